# Optimizing an MI355X kernel written in HIP

```python
import jax
import jax.numpy as jnp
from jax import lax
import numpy as np

D_MODEL = 1024
BATCH = 4
SEQ = 4096
DEPTH = 4

CHUNK = 64
LEFT_CHUNKS = 8
BAND = (LEFT_CHUNKS + 1) * CHUNK
N_AB_LAYERS = (DEPTH + 1) // 2
N_C_LAYERS = DEPTH // 2
A_HEADS = 8
A_HEAD_DIM = 64
A_WIDTH = A_HEADS * A_HEAD_DIM
REL_CLIP = 128
B_HEADS = 8
B_HEAD_SIZE = 64
B_WIDTH = B_HEADS * B_HEAD_SIZE
W_LORA = 64
A_LORA = 64
G_LORA = 128
V_LORA = 32
DECAY_SCALE = 0.606531
GN_EPS = 64e-5
B_COLS = 3 * B_WIDTH + W_LORA + A_LORA + G_LORA
B_SPLITS = (B_WIDTH, 2 * B_WIDTH, 3 * B_WIDTH, 3 * B_WIDTH + W_LORA, 3 * B_WIDTH + W_LORA + A_LORA)
AB_IN_COLS = 3 * A_WIDTH + B_COLS
AB_MIX_WIDTH = A_WIDTH + B_WIDTH
D_RNN = 1280
C_BLOCKS = 10
C_BLOCK_W = D_RNN // C_BLOCKS
CONV_W = 4
RG_C = 8.0
D_FF = 2816
NORM_EPS = 1e-6
NEG_INF = -1e30

kernel_name = 'hybrid_chunked_attn_rwkv7_rglru_macaron'


def rmsnorm(x, g):
    xf = x.astype(jnp.float32)
    y = xf * lax.rsqrt(jnp.mean(xf * xf, axis=-1, keepdims=True) + NORM_EPS)
    return (y * g.astype(jnp.float32)).astype(x.dtype)


def swiglu(h, w_gate, w_up, w_down):
    return (jax.nn.silu(h @ w_gate) * (h @ w_up)) @ w_down


def chunk_attention(q, k, v, rel_bias):
    bsz, seq = q.shape[0], q.shape[1]
    nc = seq // CHUNK
    shp = (bsz, nc, CHUNK, A_HEADS, A_HEAD_DIM)
    qc = q.reshape(shp) * (A_HEAD_DIM ** -0.5)
    pad = ((0, 0), (LEFT_CHUNKS, 0), (0, 0), (0, 0), (0, 0))
    kp = jnp.pad(k.reshape(shp), pad)
    vp = jnp.pad(v.reshape(shp), pad)
    kb = jnp.concatenate([kp[:, j:j + nc] for j in range(LEFT_CHUNKS + 1)], axis=2)
    vb = jnp.concatenate([vp[:, j:j + nc] for j in range(LEFT_CHUNKS + 1)], axis=2)
    s = jnp.einsum('bnqhd,bnkhd->bhnqk', qc, kb).astype(jnp.float32)
    dist = np.arange(CHUNK)[:, None] + LEFT_CHUNKS * CHUNK - np.arange(BAND)[None, :]
    idx = np.clip(dist, -REL_CLIP, REL_CLIP) + REL_CLIP
    s = s + rel_bias[:, idx].astype(jnp.float32)[None, :, None]
    key_chunk = np.arange(nc)[:, None] - LEFT_CHUNKS + (np.arange(BAND) // CHUNK)[None, :]
    s = jnp.where((key_chunk >= 0)[None, None, :, None, :], s, NEG_INF)
    p = jax.nn.softmax(s, axis=-1).astype(v.dtype)
    o = jnp.einsum('bhnqk,bnkhd->bnqhd', p, vb)
    return o.reshape(bsz, seq, A_WIDTH)


def _heads(t):
    return t.reshape(t.shape[0], t.shape[1], B_HEADS, B_HEAD_SIZE)


def rwkv7_scan(r, decay, k, v, kk, kka):
    def step(state, inp):
        r_t, w_t, k_t, v_t, kk_t, kka_t = inp
        sa = jnp.einsum('bhvk,bhk->bhv', state, kk_t)
        state = (state * w_t[:, :, None, :] - sa[..., None] * kka_t[:, :, None, :]
                 + v_t[..., None] * k_t[:, :, None, :])
        return state, jnp.einsum('bhvk,bhk->bhv', state, r_t)
    xs = tuple(jnp.moveaxis(t, 1, 0) for t in (r, decay, k, v, kk, kka))
    s0 = jnp.zeros((r.shape[0], B_HEADS, B_HEAD_SIZE, B_HEAD_SIZE), jnp.float32)
    _, o = lax.scan(step, s0, xs)
    return jnp.moveaxis(o, 0, 1)


def rwkv7_group(p, mu, w0, w_up, a0, a_up, g_up, k_k, k_a, r_k, ln_w, ln_b, v_first, v_mix):
    f32 = jnp.float32
    prev = jnp.pad(p, ((0, 0), (1, 0), (0, 0)))[:, :-1]
    p = p + (prev - p) * mu
    r, k, v, wd, ad, gd = jnp.split(p, B_SPLITS, axis=-1)
    v_raw = v
    if v_mix is not None:
        v0, v_down, v_up = v_mix
        v = v + (v_first - v) * jax.nn.sigmoid(v0 + (v @ v_down) @ v_up)
    decay = jnp.exp(-DECAY_SCALE * jax.nn.sigmoid((w0 + jnp.tanh(wd) @ w_up).astype(f32)))
    a = jax.nn.sigmoid(a0 + ad @ a_up).astype(f32)
    g = jax.nn.sigmoid(gd) @ g_up
    kk = _heads((k * k_k).astype(f32))
    kk = kk * lax.rsqrt(jnp.maximum(jnp.sum(kk * kk, axis=-1, keepdims=True), 1e-24))
    k = k.astype(f32) * (1.0 + (a - 1.0) * k_a.astype(f32))
    rh, kh, vh, ah = _heads(r.astype(f32)), _heads(k), _heads(v.astype(f32)), _heads(a)
    o = rwkv7_scan(rh, _heads(decay), kh, vh, kk, kk * ah)
    mean = jnp.mean(o, axis=-1, keepdims=True)
    var = jnp.mean(jnp.square(o - mean), axis=-1, keepdims=True)
    o = (o - mean) * lax.rsqrt(var + GN_EPS)
    o = (o * ln_w.astype(f32).reshape(B_HEADS, B_HEAD_SIZE)
         + ln_b.astype(f32).reshape(B_HEADS, B_HEAD_SIZE))
    o = o + jnp.sum(rh * kh * r_k.astype(f32), axis=-1, keepdims=True) * vh
    o = o.reshape(o.shape[0], o.shape[1], B_WIDTH) * g.astype(f32)
    return o.astype(p.dtype), v_raw


def _lin_combine(c1, c2):
    a1, b1 = c1
    a2, b2 = c2
    return a1 * a2, a2 * b1 + b2


def rglru_block(h, w_in, conv_w, conv_b, wa, ba, wx, bx, lam, w_out):
    f32 = jnp.float32
    gate, xb = jnp.split(h @ w_in, 2, axis=-1)
    gate = jax.nn.gelu(gate)
    xc = lax.conv_general_dilated(xb, conv_w[:, None, :], window_strides=(1,),
                                  padding=[(CONV_W - 1, 0)],
                                  dimension_numbers=('NWC', 'WIO', 'NWC'),
                                  feature_group_count=D_RNN) + conv_b
    xblk = xc.reshape(xc.shape[0], xc.shape[1], C_BLOCKS, C_BLOCK_W)
    r = jax.nn.sigmoid((jnp.einsum('bsnc,ncd->bsnd', xblk, wa).reshape(xc.shape) + ba).astype(f32))
    ig = jax.nn.sigmoid((jnp.einsum('bsnc,ncd->bsnd', xblk, wx).reshape(xc.shape) + bx).astype(f32))
    log_a = -RG_C * r * jax.nn.softplus(-lam.astype(f32))
    a = jnp.exp(log_a)
    mult = jnp.sqrt(jnp.maximum(-jnp.expm1(2.0 * log_a), 0.0))
    b = mult * ig * xc.astype(f32)
    _, hs = lax.associative_scan(_lin_combine, (a, b), axis=1)
    return (hs.astype(h.dtype) * gate) @ w_out


def setup_inputs(seed: int = 0) -> dict:
    key = jax.random.key(seed)
    ks = iter(jax.random.split(key, 48))
    f32 = jnp.float32

    def nrm(shape, scale):
        return jax.random.normal(next(ks), shape, f32) * scale

    def uni(shape, lo, hi):
        return jax.random.uniform(next(ks), shape, f32, lo, hi)

    na, nc = N_AB_LAYERS, N_C_LAYERS
    u = uni((nc, D_RNN), 0.9, 0.999)
    sig = u ** (1.0 / RG_C)
    lam = jnp.log(sig) - jnp.log1p(-sig)
    return {
        'x': nrm((BATCH, SEQ, D_MODEL), 1.0),
        'norm_ffn': 1.0 + nrm((DEPTH, 2, D_MODEL), 0.02),
        'ffn_w_gate': nrm((DEPTH, 2, D_MODEL, D_FF), D_MODEL ** -0.5),
        'ffn_w_up': nrm((DEPTH, 2, D_MODEL, D_FF), D_MODEL ** -0.5),
        'ffn_w_down': nrm((DEPTH, 2, D_FF, D_MODEL), D_FF ** -0.5),
        'norm_mix': 1.0 + nrm((DEPTH, D_MODEL), 0.02),
        'ab_w_in': nrm((na, D_MODEL, AB_IN_COLS), D_MODEL ** -0.5),
        'ab_w_out': nrm((na, AB_MIX_WIDTH, D_MODEL), AB_MIX_WIDTH ** -0.5),
        'att_rel_bias': nrm((na, A_HEADS, 2 * REL_CLIP + 1), 0.5),
        'rwkv_mu': uni((na, B_COLS), 0.0, 1.0),
        'rwkv_w0': uni((na, B_WIDTH), -5.0, 1.0),
        'rwkv_w_up': nrm((na, W_LORA, B_WIDTH), W_LORA ** -0.5),
        'rwkv_a0': nrm((na, B_WIDTH), 0.1),
        'rwkv_a_up': nrm((na, A_LORA, B_WIDTH), A_LORA ** -0.5),
        'rwkv_g_up': nrm((na, G_LORA, B_WIDTH), G_LORA ** -0.5),
        'rwkv_k_k': 0.85 + nrm((na, B_WIDTH), 0.02),
        'rwkv_k_a': 1.0 + nrm((na, B_WIDTH), 0.02),
        'rwkv_r_k': nrm((na, B_HEADS, B_HEAD_SIZE), 0.1),
        'rwkv_ln_w': 1.0 + nrm((na, B_WIDTH), 0.02),
        'rwkv_ln_b': nrm((na, B_WIDTH), 0.02),
        'rwkv_v0': nrm((na - 1, B_WIDTH), 0.1),
        'rwkv_v_down': nrm((na - 1, B_WIDTH, V_LORA), B_WIDTH ** -0.5),
        'rwkv_v_up': nrm((na - 1, V_LORA, B_WIDTH), V_LORA ** -0.5),
        'c_w_in': nrm((nc, D_MODEL, 2 * D_RNN), D_MODEL ** -0.5),
        'c_conv_w': nrm((nc, CONV_W, D_RNN), CONV_W ** -0.5),
        'c_conv_b': nrm((nc, D_RNN), 0.02),
        'c_wa': nrm((nc, C_BLOCKS, C_BLOCK_W, C_BLOCK_W), C_BLOCK_W ** -0.5),
        'c_ba': nrm((nc, D_RNN), 0.02),
        'c_wx': nrm((nc, C_BLOCKS, C_BLOCK_W, C_BLOCK_W), C_BLOCK_W ** -0.5),
        'c_bx': nrm((nc, D_RNN), 0.02),
        'c_lambda': lam,
        'c_w_out': nrm((nc, D_RNN, D_MODEL), D_RNN ** -0.5),
        'norm_final': 1.0 + nrm((D_MODEL,), 0.02),
    }


def reference(x, norm_ffn, ffn_w_gate, ffn_w_up, ffn_w_down, norm_mix, ab_w_in, ab_w_out,
              att_rel_bias, rwkv_mu, rwkv_w0, rwkv_w_up, rwkv_a0, rwkv_a_up, rwkv_g_up,
              rwkv_k_k, rwkv_k_a, rwkv_r_k, rwkv_ln_w, rwkv_ln_b, rwkv_v0, rwkv_v_down,
              rwkv_v_up, c_w_in, c_conv_w, c_conv_b, c_wa, c_ba, c_wx, c_bx, c_lambda,
              c_w_out, norm_final):
    v_first = None
    for l in range(DEPTH):
        x = x + 0.5 * swiglu(rmsnorm(x, norm_ffn[l, 0]), ffn_w_gate[l, 0], ffn_w_up[l, 0], ffn_w_down[l, 0])
        h = rmsnorm(x, norm_mix[l])
        if l % 2 == 0:
            i = l // 2
            p = h @ ab_w_in[i]
            qa, ka, va, pb = jnp.split(p, [A_WIDTH, 2 * A_WIDTH, 3 * A_WIDTH], axis=-1)
            oa = chunk_attention(qa, ka, va, att_rel_bias[i])
            v_mix = None if i == 0 else (rwkv_v0[i - 1], rwkv_v_down[i - 1], rwkv_v_up[i - 1])
            ob, v_b = rwkv7_group(pb, rwkv_mu[i], rwkv_w0[i], rwkv_w_up[i], rwkv_a0[i], rwkv_a_up[i],
                                  rwkv_g_up[i], rwkv_k_k[i], rwkv_k_a[i], rwkv_r_k[i],
                                  rwkv_ln_w[i], rwkv_ln_b[i], v_first, v_mix)
            if i == 0:
                v_first = v_b
            x = x + jnp.concatenate([oa, ob], axis=-1) @ ab_w_out[i]
        else:
            j = l // 2
            x = x + rglru_block(h, c_w_in[j], c_conv_w[j], c_conv_b[j], c_wa[j], c_ba[j],
                                c_wx[j], c_bx[j], c_lambda[j], c_w_out[j])
        x = x + 0.5 * swiglu(rmsnorm(x, norm_ffn[l, 1]), ffn_w_gate[l, 1], ffn_w_up[l, 1], ffn_w_down[l, 1])
    return rmsnorm(x, norm_final)
```

```cpp
#include <hip/hip_runtime.h>
#include <hip/hip_cooperative_groups.h>
#include <cstdio>
namespace cg = cooperative_groups;
#ifndef MODE_COOP
#define MODE_COOP 0
#endif
__device__ __forceinline__ int o_tid() { int t = threadIdx.x; asm volatile("" : "+v"(t)); return t; }
__device__ __forceinline__ int o_bid() { int t = blockIdx.x; asm volatile("" : "+s"(t)); return t; }
__device__ __forceinline__ int o_grid() { int t = gridDim.x; asm volatile("" : "+s"(t)); return t; }
namespace pg8 {
#define PG8_LAS __attribute__((address_space(3)))
typedef unsigned short bf16_t;
typedef short bf16x8 __attribute__((ext_vector_type(8)));
typedef float f32x4 __attribute__((ext_vector_type(4)));
typedef unsigned u32x4 __attribute__((ext_vector_type(4)));
constexpr int BM = 256, BK = 64, HALF = 128, HTB = HALF * BK * 2  , STAGE_BYTES = 8 * HTB, NXCD = 8, WGM = 8;

__host__ __device__ __forceinline__ int lds_byte(int r, int c) { const int st = (r >> 4) * 2 + (c >> 5), rr = r & 15, cc = c & 31, ob = rr * 64 + cc * 2; return st * 1024 + (ob ^ (((ob >> 9) & 1) << 5)); }
__host__ __device__ __forceinline__ void stage_rc(int b, int& R, int& C) { const int st = b / 1024, sb = b % 1024, swz = sb ^ (((sb >> 9) & 1) << 5); R = (st >> 1) * 16 + swz / 64; C = (st & 1) * 32 + (swz % 64) / 2; }
__host__ __device__ __forceinline__ int perm32(int rho) { const int n = rho >> 4, i = rho & 15; return 8 * (i >> 2) + 4 * n + (i & 3); }

struct Unit { int pm, pn; };
struct Gemm { const bf16_t* A; const bf16_t* Bt; int M, N, K; };

struct StaticOrder {
    int nM, nN, nwg, G, c;
    __host__ __device__ void init(int M, int N, int G_, int c_) { nM = M / BM; nN = N / BM; nwg = nM * nN; G = G_; c = c_; }
    __host__ __device__ bool next(int i, Unit& u) const {
        const long L = (long)i * G + c; if (L >= nwg) return false;
        int wgid = (int)L; { const int q = nwg / NXCD, r = nwg % NXCD, xcd = wgid % NXCD, off = wgid / NXCD; wgid = (xcd < r ? xcd * (q + 1) : r * (q + 1) + (xcd - r) * q) + off; }
        const int nig = WGM * nN, gid = wgid / nig, fm = gid * WGM, gsz = (nM - fm) < WGM ? (nM - fm) : WGM;
        u.pm = fm + ((wgid % nig) % gsz); u.pn = (wgid % nig) / gsz; return true;
    }
    __device__ __forceinline__ void a_ready(const Unit&) const {}
    __device__ __forceinline__ void done(const Unit&) const {}
};
__device__ __forceinline__ unsigned cvt_pk_bf16(float lo, float hi) { unsigned r; asm volatile("v_cvt_pk_bf16_f32 %0, %1, %2" : "=v"(r) : "v"(lo), "v"(hi)); return r; }
typedef float f32x2 __attribute__((ext_vector_type(2)));
template <class Epi, class Sched, bool STAMP = false>
__device__ __forceinline__ void gemm_phase(PG8_LAS unsigned char* lds, const Gemm g, const Sched& S, const Epi& E, unsigned long long* stamps) {
    const int tid = o_tid(), wid = __builtin_amdgcn_readfirstlane(tid >> 6), lane = tid & 63, wr = wid >> 2, wc = wid & 3, fr = lane & 15, fq = lane >> 4;
    int Kq_ = g.K; asm volatile("" : "+s"(Kq_)); const int K = Kq_, nt = K / BK;
    int ts_lo = 0, ts_hi = 0, nts = 0; const unsigned long long rt_entry = STAMP ? (unsigned long long)wall_clock64() : 0ull;
#define PG8_STAMP() do { if (STAMP && wid == 0 && nts < 64) { const unsigned long long _c = (unsigned long long)clock64(); \
        ts_lo = (lane == nts) ? (int)(unsigned)_c : ts_lo; ts_hi = (lane == nts) ? (int)(unsigned)(_c >> 32) : ts_hi; ++nts; } } while (0)
    PG8_STAMP();
    unsigned voffA[2], voffB[2];
#pragma unroll
    for (int i = 0; i < 2; ++i) { int R, C; stage_rc(tid * 16 + i * 8192, R, C); const int Rb = Epi::PERM ? ((R & ~31) + perm32(R & 31)) : R;
        voffA[i] = (unsigned)(R * K + C) * 2u; voffB[i] = (unsigned)(Rb * K + C) * 2u; }
    const size_t kstep = (size_t)(BK * 2);
    const size_t hstep = (size_t)HALF * K * 2;
    const size_t tstep = 2 * hstep;
    const unsigned ldsw = (unsigned)wid * 1024u;
    const int aoff = lds_byte(wr * 64 + fr, fq * 8), boff = lds_byte(wc * 32 + fr, fq * 8);
#define PG8_SA(b, h) (((b) * 2 + (h)) * HTB)
#define PG8_SB(b, h) ((4 + (b) * 2 + (h)) * HTB)
#define PG8_STAGE(bufoff, gbase, voff) do { _Pragma("unroll") for (int _i = 0; _i < 2; ++_i) \
        __builtin_amdgcn_global_load_lds((const unsigned*)((const char*)(gbase) + (voff)[_i]), (PG8_LAS unsigned*)(lds + (bufoff) + ldsw + _i * 8192), 16, 0, 0); } while (0)
#define PG8_LDA(dst, b, h) do { _Pragma("unroll") for (int m = 0; m < 4; ++m) _Pragma("unroll") for (int k = 0; k < 2; ++k) dst[m][k] = *(const PG8_LAS bf16x8*)(lds + PG8_SA(b, h) + aoff + m * 2048 + k * 1024); } while (0)
#define PG8_LDB(dst, b, h) do { _Pragma("unroll") for (int n = 0; n < 2; ++n) _Pragma("unroll") for (int k = 0; k < 2; ++k) dst[n][k] = *(const PG8_LAS bf16x8*)(lds + PG8_SB(b, h) + boff + n * 2048 + k * 1024); } while (0)
#define PG8_MMA(ai, bj, At, Bt) do { __builtin_amdgcn_s_setprio(1); _Pragma("unroll") for (int m = 0; m < 4; ++m) _Pragma("unroll") for (int n = 0; n < 2; ++n) _Pragma("unroll") for (int k = 0; k < 2; ++k) \
        acc[ai][bj][m][n] = __builtin_amdgcn_mfma_f32_16x16x32_bf16(Bt[n][k], At[m][k], acc[ai][bj][m][n], 0, 0, 0); __builtin_amdgcn_s_setprio(0); } while (0)
#define PG8_WAIT_V(n) asm volatile("s_waitcnt vmcnt(" #n ")" ::: "memory")
#define PG8_WAIT_L(n) asm volatile("s_waitcnt lgkmcnt(" #n ")" ::: "memory")
#define PG8_BAR __builtin_amdgcn_s_barrier()
#define PG8_SCHED __builtin_amdgcn_sched_barrier(0)
    Unit cur, nxt; int ui = 0;
    if (!S.next(0, cur)) return;
    f32x4 acc[2][2][4][2];
#pragma unroll
    for (int a = 0; a < 2; ++a)
#pragma unroll
        for (int b = 0; b < 2; ++b)
#pragma unroll
            for (int m = 0; m < 4; ++m)
#pragma unroll
                for (int n = 0; n < 2; ++n) acc[a][b][m][n] = (f32x4){0.f, 0.f, 0.f, 0.f};
    bf16x8 At[4][2], B0[2][2], B1[2][2];
    const char* cA = (const char*)g.A + (size_t)cur.pm * tstep; const char* cB = (const char*)g.Bt + (size_t)cur.pn * tstep;
    S.a_ready(cur);
    PG8_STAGE(PG8_SB(0, 0), cB, voffB); PG8_STAGE(PG8_SA(0, 0), cA, voffA); PG8_STAGE(PG8_SB(0, 1), cB + hstep, voffB); PG8_STAGE(PG8_SA(0, 1), cA + hstep, voffA);
    if (wr == 1) PG8_BAR;
    PG8_WAIT_V(4); PG8_BAR;
    PG8_STAGE(PG8_SB(1, 0), cB + kstep, voffB); PG8_STAGE(PG8_SA(1, 0), cA + kstep, voffA); PG8_STAGE(PG8_SB(1, 1), cB + hstep + kstep, voffB);
    PG8_WAIT_V(6); PG8_BAR;
    PG8_STAMP();
    for (;;) {
        const bool has_next = S.next(ui + 1, nxt);
        const char* nA = has_next ? (const char*)g.A + (size_t)nxt.pm * tstep : cA; const char* nB = has_next ? (const char*)g.Bt + (size_t)nxt.pn * tstep : cB;
        for (int t = 0; t < nt; t += 2) {
            const bool last = (t == nt - 2);
            const char* a1 = cA + (size_t)(t + 1) * kstep;
            const char* a2 = last ? nA : cA + (size_t)(t + 2) * kstep; const char* b2 = last ? nB : cB + (size_t)(t + 2) * kstep;
            const char* a3 = a2 + kstep; const char* b3 = b2 + kstep;
            if (last && has_next) S.a_ready(nxt);
            PG8_LDB(B0, 0, 0); PG8_SCHED; PG8_LDA(At, 0, 0); PG8_STAGE(PG8_SA(1, 1), a1 + hstep, voffA);
            PG8_WAIT_L(8); PG8_BAR; PG8_WAIT_L(0); PG8_MMA(0, 0, At, B0); PG8_BAR; PG8_SCHED;
            PG8_LDB(B1, 0, 1); PG8_STAGE(PG8_SB(0, 0), b2, voffB);
            PG8_BAR; PG8_WAIT_L(0); PG8_MMA(0, 1, At, B1); PG8_BAR;
            PG8_LDA(At, 0, 1); PG8_STAGE(PG8_SA(0, 0), a2, voffA);
            PG8_BAR; PG8_WAIT_L(0); PG8_MMA(1, 0, At, B0); PG8_BAR; PG8_SCHED;
            PG8_STAGE(PG8_SB(0, 1), b2 + hstep, voffB);
            PG8_WAIT_V(6); PG8_BAR; PG8_MMA(1, 1, At, B1); PG8_BAR;
            PG8_LDB(B0, 1, 0); PG8_SCHED; PG8_LDA(At, 1, 0); PG8_STAGE(PG8_SA(0, 1), a2 + hstep, voffA);
            PG8_WAIT_L(8); PG8_BAR; PG8_WAIT_L(0); PG8_MMA(0, 0, At, B0); PG8_BAR; PG8_SCHED;
            PG8_LDB(B1, 1, 1); PG8_STAGE(PG8_SB(1, 0), b3, voffB);
            PG8_BAR; PG8_WAIT_L(0); PG8_MMA(0, 1, At, B1); PG8_BAR;
            PG8_LDA(At, 1, 1); PG8_STAGE(PG8_SA(1, 0), a3, voffA);
            PG8_BAR; PG8_WAIT_L(0); PG8_MMA(1, 0, At, B0); PG8_BAR; PG8_SCHED;
            PG8_STAGE(PG8_SB(1, 1), b3 + hstep, voffB);
            PG8_WAIT_V(6); PG8_BAR; PG8_MMA(1, 1, At, B1); PG8_BAR;
        }
        PG8_STAMP();
        if constexpr (!Epi::AFTER_DRAIN) { E(acc, cur, wr, wc, fr, fq); S.done(cur); }
        PG8_STAMP();
        if (!has_next) break;
#pragma unroll
        for (int a = 0; a < 2; ++a)
#pragma unroll
            for (int b = 0; b < 2; ++b)
#pragma unroll
                for (int m = 0; m < 4; ++m)
#pragma unroll
                    for (int n = 0; n < 2; ++n) acc[a][b][m][n] = (f32x4){0.f, 0.f, 0.f, 0.f};
        cur = nxt; cA = nA; cB = nB; ++ui;
    }
    PG8_WAIT_V(0);
    if (wr == 0) PG8_BAR;
    PG8_BAR;
    if constexpr (Epi::AFTER_DRAIN) { E.fused(acc, cur, wr, wc, fr, fq, lds, wid, lane); S.done(cur); }
    PG8_STAMP();
    if (STAMP && wid == 0) { stamps[lane] = lane < nts ? (((unsigned long long)(unsigned)ts_hi << 32) | (unsigned)ts_lo) : 0ull;
        if (lane == 62) stamps[62] = rt_entry; if (lane == 63) stamps[63] = (unsigned long long)wall_clock64(); }
#undef PG8_STAMP
#undef PG8_SA
#undef PG8_SB
#undef PG8_STAGE
#undef PG8_LDA
#undef PG8_LDB
#undef PG8_MMA
#undef PG8_WAIT_V
#undef PG8_WAIT_L
#undef PG8_BAR
#undef PG8_SCHED
}
}

using pg8::bf16_t; using pg8::bf16x8; using pg8::f32x4; using pg8::u32x4; using pg8::Unit; using pg8::BM; using pg8::HALF;
typedef unsigned u32x2 __attribute__((ext_vector_type(2)));
#define LAS __attribute__((address_space(3)))
#define CAS __attribute__((address_space(4)))
typedef const CAS float* cfp;

constexpr int MT = 16384, SEQ = 4096, DM = 1024, DFF = 2816;
constexpr int LDS_BYTES = 131072;

constexpr size_t SZ_WGU = 5632ull * 1024 * 2, SZ_WD = 1024ull * 2816 * 2;
constexpr size_t OFF_WGU = 0, OFF_WD = OFF_WGU + SZ_WGU, END_WFFN = OFF_WD + SZ_WD;
constexpr size_t OFF_WIN = 0, OFF_WOUT = OFF_WIN + 3328ull * 1024 * 2, OFF_WLORA = OFF_WOUT + 1024ull * 1024 * 2, OFF_WV = OFF_WLORA + 1536ull * 256 * 2, END_WEVEN = OFF_WV + 512ull * 512 * 2;
constexpr size_t OFF_CIN = 0, OFF_COUT = OFF_CIN + 2560ull * 1024 * 2, OFF_WGATES = OFF_COUT + 1024ull * 1280 * 2, END_WODD = OFF_WGATES + 2560ull * 256 * 2;
static_assert(END_WEVEN <= END_WFFN && END_WODD <= END_WFFN, "W region");
constexpr size_t OFF_HN = END_WFFN;
constexpr size_t OFF_VF = OFF_HN + (size_t)MT * 1024 * 2;
constexpr size_t OFF_AR = OFF_VF + (size_t)MT * 512 * 2;
constexpr size_t SLOT = (size_t)MT * 512 * 4, SZ_B512 = (size_t)MT * 512 * 2;
constexpr size_t OFF_FF = OFF_AR;
struct EvenMap { size_t w, kka, r, k, kk, P, vsh, al, g, v2, pm, hm; };
__device__ __forceinline__ EvenMap even_map(int i2) {
    EvenMap m;
    if (i2 == 0) { m.w = 0; m.kka = SLOT; m.r = 2 * SLOT; m.k = 3 * SLOT; m.kk = 4 * SLOT; m.P = 5 * SLOT; m.vsh = 8 * SLOT + SLOT / 4; m.al = 8 * SLOT + 3 * SLOT / 4; m.g = 5 * SLOT; m.v2 = 5 * SLOT + SLOT / 2; m.pm = 6 * SLOT; m.hm = 7 * SLOT; }
    else         { m.w = 5 * SLOT; m.kka = 6 * SLOT; m.r = 7 * SLOT; m.k = 8 * SLOT; m.kk = 9 * SLOT; m.P = 0; m.vsh = 3 * SLOT + SLOT / 4; m.al = 3 * SLOT + 3 * SLOT / 4; m.g = 4 * SLOT; m.v2 = 4 * SLOT + SLOT / 2; m.pm = 0; m.hm = SLOT; }
    return m; }
static_assert((size_t)MT * 3328 * 2 <= 3 * SLOT + SLOT / 4, "P fits 3.25 slots");
constexpr size_t OFF_P2 = OFF_AR;
constexpr size_t OFF_XC = OFF_P2 + (size_t)MT * 2560 * 2;
constexpr size_t OFF_XCG = OFF_XC + (size_t)MT * 1280 * 4;
constexpr size_t OFF_A = OFF_XCG + (size_t)MT * 1280 * 2;
constexpr size_t OFF_SA = OFF_A + (size_t)MT * 1280 * 4, OFF_SH = OFF_SA + 4ull * 64 * 1280 * 4, END_ODD = OFF_SH + 4ull * 64 * 1280 * 4;
constexpr size_t WS_NEED = OFF_AR + 10 * SLOT;
static_assert(END_ODD <= WS_NEED, "odd map");
static_assert(WS_NEED <= 410000000ull, "workspace map too large");

struct Params { const float* in[33]; float* out; unsigned char* ws; };
enum { I_X = 0, I_NFFN, I_WG, I_WU, I_WDN, I_NMIX, I_ABIN, I_ABOUT, I_RELB, I_MU, I_W0, I_WUP, I_A0, I_AUP, I_GUP, I_KK, I_KA, I_RK, I_LNW, I_LNB, I_V0, I_VDN, I_VUP,
       I_CIN, I_CCW, I_CCB, I_CWA, I_CBA, I_CWX, I_CBX, I_LAM, I_COUT, I_NFIN };

__device__ __forceinline__ const float* pin(const Params& p, int i) { asm volatile("" : "+s"(i)); return p.in[i]; }
__device__ __forceinline__ float bf2f(unsigned u16) { return __uint_as_float(u16 << 16); }
__device__ __forceinline__ unsigned pk(float a, float b) { return pg8::cvt_pk_bf16(a, b); }
__device__ __forceinline__ bf16_t f2bf(float a) { return (bf16_t)(pg8::cvt_pk_bf16(a, 0.f) & 0xffffu); }
__device__ __forceinline__ float sigm(float x) { return __builtin_amdgcn_rcpf(1.0f + __expf(-x)); }
__device__ __forceinline__ float wsum(float v) {
#pragma unroll
    for (int o = 32; o >= 1; o >>= 1) v += __shfl_xor(v, o);
    return v; }

struct EpiSwiglu {
    static constexpr bool PERM = true, AFTER_DRAIN = false;
    bf16_t* O;
    __device__ __forceinline__ void operator()(const f32x4 (&acc)[2][2][4][2], const Unit& u, int wr, int wc, int fr, int fq) const {
        const int row0 = u.pm * BM + wr * 64 + fr, col0 = u.pn * 128 + wc * 32 + 8 * fq;
#pragma unroll
        for (int ai = 0; ai < 2; ++ai)
#pragma unroll
            for (int m = 0; m < 4; ++m) {
                bf16_t* rowp = O + (size_t)(row0 + ai * HALF + m * 16) * DFF + col0;
                float hv[8];
#pragma unroll
                for (int n = 0; n < 2; ++n)
#pragma unroll
                    for (int j = 0; j < 4; ++j) { const float g = acc[ai][0][m][n][j], uu = acc[ai][1][m][n][j]; hv[n * 4 + j] = g * sigm(g) * uu; }
                u32x4 w; w.x = pk(hv[0], hv[1]); w.y = pk(hv[2], hv[3]); w.z = pk(hv[4], hv[5]); w.w = pk(hv[6], hv[7]);
                *(u32x4*)rowp = w;
            }
    }
};
struct EpiResid {
    static constexpr bool PERM = true, AFTER_DRAIN = false;
    const float* src; float* dst; float scale;
    __device__ __forceinline__ void operator()(const f32x4 (&acc)[2][2][4][2], const Unit& u, int wr, int wc, int fr, int fq) const {
        const int row0 = u.pm * BM + wr * 64 + fr, col0 = u.pn * BM + wc * 32 + 8 * fq;
#pragma unroll
        for (int ai = 0; ai < 2; ++ai)
#pragma unroll
            for (int m = 0; m < 4; ++m) {
                const size_t off = (size_t)(row0 + ai * HALF + m * 16) * DM + col0;
#pragma unroll
                for (int bj = 0; bj < 2; ++bj)
#pragma unroll
                    for (int n = 0; n < 2; ++n) { f32x4 v = *(const f32x4*)(src + off + bj * HALF + 4 * n); v = v + acc[ai][bj][m][n] * scale; *(f32x4*)(dst + off + bj * HALF + 4 * n) = v; }
            }
    }
};
__device__ __forceinline__ float gelu_tanh(float x) { const float u2 = 1.5957691216f * (x + 0.044715f * x * x * x); return x * sigm(u2); }
struct EpiBf16Act {
    static constexpr bool PERM = true, AFTER_DRAIN = false;
    bf16_t* O; int ldc; int gelu_tiles;
    __device__ __forceinline__ void operator()(const f32x4 (&acc)[2][2][4][2], const Unit& u, int wr, int wc, int fr, int fq) const {
        const int row0 = u.pm * BM + wr * 64 + fr, col0 = u.pn * BM + wc * 32 + 8 * fq; const bool act = u.pn < gelu_tiles;
#pragma unroll
        for (int ai = 0; ai < 2; ++ai)
#pragma unroll
            for (int m = 0; m < 4; ++m) {
                bf16_t* rowp = O + (size_t)(row0 + ai * HALF + m * 16) * ldc + col0;
#pragma unroll
                for (int bj = 0; bj < 2; ++bj) {
                    f32x4 v0 = acc[ai][bj][m][0], v1 = acc[ai][bj][m][1];
                    if (act) {
#pragma unroll
                        for (int j = 0; j < 4; ++j) { v0[j] = gelu_tanh(v0[j]); v1[j] = gelu_tanh(v1[j]); } }
                    u32x4 w; w.x = pk(v0[0], v0[1]); w.y = pk(v0[2], v0[3]); w.z = pk(v1[0], v1[1]); w.w = pk(v1[2], v1[3]);
                    *(u32x4*)(rowp + bj * HALF) = w;
                }
            }
    }
};
struct EpiLora {
    static constexpr bool PERM = true, AFTER_DRAIN = false;
    float* wbuf; float* kbuf; const float* kkbuf; float* kkabuf; bf16_t* gbuf; const float* w0; const float* a0; const float* k_a;
    __device__ __forceinline__ void operator()(const f32x4 (&acc)[2][2][4][2], const Unit& u, int wr, int wc, int fr, int fq) const {
        const int row0 = u.pm * BM + wr * 64 + fr, seg = u.pn >> 1, cl0 = (u.pn & 1) * 256 + wc * 32 + 8 * fq;
        if (seg == 0) {
#pragma unroll
            for (int ai = 0; ai < 2; ++ai)
#pragma unroll
                for (int m = 0; m < 4; ++m) { const size_t off = (size_t)(row0 + ai * HALF + m * 16) * 512 + cl0;
#pragma unroll
                    for (int bj = 0; bj < 2; ++bj)
#pragma unroll
                        for (int n = 0; n < 2; ++n) { const int cc = bj * HALF + 4 * n; const f32x4 b0 = *(const f32x4*)(w0 + cl0 + cc); f32x4 o;
#pragma unroll
                            for (int j = 0; j < 4; ++j) o[j] = __expf(-0.606531f * sigm(b0[j] + acc[ai][bj][m][n][j]));
                            *(f32x4*)(wbuf + off + cc) = o; }
                    __builtin_amdgcn_sched_barrier(0); }
        } else if (seg == 1) {
#pragma unroll
            for (int ai = 0; ai < 2; ++ai)
#pragma unroll
                for (int m = 0; m < 4; ++m) { const size_t off = (size_t)(row0 + ai * HALF + m * 16) * 512 + cl0;
#pragma unroll
                    for (int bj = 0; bj < 2; ++bj)
#pragma unroll
                        for (int n = 0; n < 2; ++n) { const int cc = bj * HALF + 4 * n; const f32x4 b0 = *(const f32x4*)(a0 + cl0 + cc), ka = *(const f32x4*)(k_a + cl0 + cc);
                            const f32x4 kv = *(const f32x4*)(kbuf + off + cc), kk = *(const f32x4*)(kkbuf + off + cc); f32x4 ko, kao;
#pragma unroll
                            for (int j = 0; j < 4; ++j) { const float a = sigm(b0[j] + acc[ai][bj][m][n][j]); ko[j] = kv[j] * (1.0f + (a - 1.0f) * ka[j]); kao[j] = kk[j] * a; }
                            *(f32x4*)(kbuf + off + cc) = ko; *(f32x4*)(kkabuf + off + cc) = kao; __builtin_amdgcn_sched_barrier(0); }
                }
        } else {
#pragma unroll
            for (int ai = 0; ai < 2; ++ai)
#pragma unroll
                for (int m = 0; m < 4; ++m) { const size_t off = (size_t)(row0 + ai * HALF + m * 16) * 512 + cl0;
#pragma unroll
                    for (int bj = 0; bj < 2; ++bj) { const f32x4 v0 = acc[ai][bj][m][0], v1 = acc[ai][bj][m][1];
                        u32x4 w; w.x = pk(v0[0], v0[1]); w.y = pk(v0[2], v0[3]); w.z = pk(v1[0], v1[1]); w.w = pk(v1[2], v1[3]); *(u32x4*)(gbuf + off + bj * HALF) = w; }
                    __builtin_amdgcn_sched_barrier(0); }
        }
    }
};
struct EpiVLora {
    static constexpr bool PERM = true, AFTER_DRAIN = false;
    const bf16_t* vsh; const bf16_t* vfirst; bf16_t* v2; const float* v0;
    __device__ __forceinline__ void operator()(const f32x4 (&acc)[2][2][4][2], const Unit& u, int wr, int wc, int fr, int fq) const {
        const int row0 = u.pm * BM + wr * 64 + fr, cl0 = u.pn * BM + wc * 32 + 8 * fq;
#pragma unroll
        for (int bj = 0; bj < 2; ++bj)
#pragma unroll
            for (int n = 0; n < 2; ++n) {
                const int c = cl0 + bj * HALF + 4 * n; const f32x4 b0 = *(const f32x4*)(v0 + c);
#pragma unroll
                for (int ai = 0; ai < 2; ++ai)
#pragma unroll
                    for (int m = 0; m < 4; ++m) { const size_t off = (size_t)(row0 + ai * HALF + m * 16) * 512 + c;
                        const u32x2 a = *(const u32x2*)(vsh + off), f = *(const u32x2*)(vfirst + off);
                        const float av[4] = {bf2f(a.x & 0xffffu), bf2f(a.x >> 16), bf2f(a.y & 0xffffu), bf2f(a.y >> 16)};
                        const float fv[4] = {bf2f(f.x & 0xffffu), bf2f(f.x >> 16), bf2f(f.y & 0xffffu), bf2f(f.y >> 16)}; float o[4];
#pragma unroll
                        for (int j = 0; j < 4; ++j) o[j] = av[j] + (fv[j] - av[j]) * sigm(b0[j] + acc[ai][bj][m][n][j]);
                        u32x2 w; w.x = pk(o[0], o[1]); w.y = pk(o[2], o[3]); *(u32x2*)(v2 + off) = w; __builtin_amdgcn_sched_barrier(0); }
            }
    }
};
struct EpiGates {
    static constexpr bool PERM = true, AFTER_DRAIN = false;
    float* xcb; float* abuf; const float* ba; const float* bx; const float* lam;
    __device__ __forceinline__ void operator()(const f32x4 (&acc)[2][2][4][2], const Unit& u, int wr, int wc, int fr, int fq) const {
        const int row0 = (u.pm & 63) * BM + wr * 64 + fr, ch0 = u.pn * 128 + wc * 32 + 8 * fq;
#pragma unroll
        for (int n = 0; n < 2; ++n) {
            const int ch = ch0 + 4 * n; const f32x4 bav = *(const f32x4*)(ba + ch), bxv = *(const f32x4*)(bx + ch), lv = *(const f32x4*)(lam + ch); f32x4 sp;
#pragma unroll
            for (int j = 0; j < 4; ++j) sp[j] = -8.0f * log1pf(expf(-lv[j]));
#pragma unroll
            for (int ai = 0; ai < 2; ++ai)
#pragma unroll
                for (int m = 0; m < 4; ++m) { const size_t off = (size_t)(row0 + ai * HALF + m * 16) * 1280 + ch; const f32x4 xc = *(const f32x4*)(xcb + off); f32x4 ao, bo;
#pragma unroll
                    for (int j = 0; j < 4; ++j) { const float r = sigm(acc[ai][0][m][n][j] + bav[j]), ig = sigm(acc[ai][1][m][n][j] + bxv[j]); const float la = sp[j] * r;
                        ao[j] = __expf(la); bo[j] = sqrtf(fmaxf(-expm1f(2.0f * la), 0.0f)) * ig * xc[j]; }
                    *(f32x4*)(abuf + off) = ao; *(f32x4*)(xcb + off) = bo; __builtin_amdgcn_sched_barrier(0); }
        }
    }
};
struct GatesOrder {
    int G, c;
    __device__ __forceinline__ bool next(int i, Unit& u) const { const int L = i * G + c; if (L >= 640) return false; const int g = L >> 7, rem = L & 127; u.pm = g * 64 + (rem >> 1); u.pn = g * 2 + (rem & 1); return true; }
    __device__ __forceinline__ void a_ready(const Unit&) const {}
    __device__ __forceinline__ void done(const Unit&) const {}
};

__device__ __forceinline__ void transpose_job(const float* src, int K, int N, bf16_t* dst, int mode, LAS float* tile) {
    const int tid = o_tid(), tn_cnt = N >> 6, ntiles = (K >> 6) * tn_cnt;
    for (int t = o_bid(); t < ntiles; t += o_grid()) {
        const int tk = t / tn_cnt, tn = t - tk * tn_cnt, k0 = tk * 64, n0 = tn * 64;
        { const int r = tid >> 4, c4 = (tid & 15) * 4;
#pragma unroll
          for (int h = 0; h < 2; ++h) { const f32x4 v = *(const f32x4*)(src + (size_t)(k0 + r + 32 * h) * N + n0 + c4); LAS float* d = tile + (r + 32 * h) * 65 + c4; d[0] = v[0]; d[1] = v[1]; d[2] = v[2]; d[3] = v[3]; } }
        __syncthreads();
        { const int n = tid >> 3, ks = (tid & 7) * 8; float v[8];
#pragma unroll
          for (int i = 0; i < 8; ++i) v[i] = tile[(ks + i) * 65 + n];
          const int gn = n0 + n; const int R = mode == 0 ? gn : ((gn >> 7) * 256 + (gn & 127) + (mode == 2 ? 128 : 0));
          u32x4 w; w.x = pk(v[0], v[1]); w.y = pk(v[2], v[3]); w.z = pk(v[4], v[5]); w.w = pk(v[6], v[7]);
          *(u32x4*)(dst + (size_t)R * K + k0 + ks) = w; }
        __syncthreads();
    }
}
__device__ __forceinline__ void convert_ffn(const Params& p, int l, int s, LAS float* tile) {
    unsigned char* ws = p.ws; const size_t wo = (size_t)(l * 2 + s) * 1024 * 2816;
    bf16_t* gu = (bf16_t*)(ws + OFF_WGU); bf16_t* dn = (bf16_t*)(ws + OFF_WD);
    transpose_job(pin(p, I_WG) + wo, 1024, 2816, gu, 1, tile);
    transpose_job(pin(p, I_WU) + wo, 1024, 2816, gu, 2, tile);
    transpose_job(pin(p, I_WDN) + wo, 2816, 1024, dn, 0, tile);
}
__device__ __forceinline__ void convert_mixer(const Params& p, int l, LAS float* tile) {
    unsigned char* ws = p.ws; const int i2 = l >> 1;
    const int gtid = o_bid() * 512 + o_tid(), gsz = o_grid() * 512;
    if ((l & 1) == 0) {
        transpose_job(pin(p, I_ABIN) + (size_t)i2 * 1024 * 3328, 1024, 3328, (bf16_t*)(ws + OFF_WIN), 0, tile);
        transpose_job(pin(p, I_ABOUT) + (size_t)i2 * 1024 * 1024, 1024, 1024, (bf16_t*)(ws + OFF_WOUT), 0, tile);
        const float* wup = pin(p, I_WUP) + (size_t)i2 * 64 * 512; const float* aup = pin(p, I_AUP) + (size_t)i2 * 64 * 512; const float* gup = pin(p, I_GUP) + (size_t)i2 * 128 * 512;
        bf16_t* wl = (bf16_t*)(ws + OFF_WLORA);
        for (int e = gtid; e < 1536 * 256; e += gsz) { const int R = e >> 8, kk = e & 255, seg = R >> 9, c = R & 511; float v = 0.f;
            if (seg == 0) { if (kk < 64) v = wup[kk * 512 + c]; } else if (seg == 1) { if (kk >= 64 && kk < 128) v = aup[(kk - 64) * 512 + c]; } else { if (kk >= 128) v = gup[(kk - 128) * 512 + c]; }
            wl[e] = f2bf(v); }
        if (i2 == 1) { const float* vd = pin(p, I_VDN); const float* vu = pin(p, I_VUP); bf16_t* wv = (bf16_t*)(ws + OFF_WV);
            for (int e = gtid; e < 512 * 512; e += gsz) { const int n = e >> 9, k = e & 511; float a = 0.f;
#pragma unroll 8
                for (int j = 0; j < 32; ++j) a = fmaf(vd[k * 32 + j], vu[j * 512 + n], a);
                wv[e] = f2bf(a); } }
    } else {
        transpose_job(pin(p, I_CIN) + (size_t)i2 * 1024 * 2560, 1024, 2560, (bf16_t*)(ws + OFF_CIN), 0, tile);
        transpose_job(pin(p, I_COUT) + (size_t)i2 * 1280 * 1024, 1280, 1024, (bf16_t*)(ws + OFF_COUT), 0, tile);
        const float* wa = pin(p, I_CWA) + (size_t)i2 * 10 * 128 * 128; const float* wx = pin(p, I_CWX) + (size_t)i2 * 10 * 128 * 128; bf16_t* wg = (bf16_t*)(ws + OFF_WGATES);
        for (int e = gtid; e < 2560 * 256; e += gsz) { const int R = e >> 8, kk = e & 255, pn = R >> 8, bj = (R >> 7) & 1, d = R & 127; float v = 0.f;
            if ((kk >> 7) == (pn & 1)) v = (bj ? wx : wa)[((size_t)pn * 128 + (kk & 127)) * 128 + d];
            wg[e] = f2bf(v); }
    }
}

template <bool FINAL> __device__ __forceinline__ void norm_phase(const float* x, const float* g, bf16_t* outb, float* outf) {
    const int wid = o_tid() >> 6, lane = o_tid() & 63;
    for (int row = o_bid() * 8 + wid; row < MT; row += o_grid() * 8) {
        const float* xr = x + (size_t)row * DM; f32x4 v[4]; float ss = 0.f;
#pragma unroll
        for (int j = 0; j < 4; ++j) { v[j] = *(const f32x4*)(xr + j * 256 + lane * 4); ss += v[j][0] * v[j][0] + v[j][1] * v[j][1] + v[j][2] * v[j][2] + v[j][3] * v[j][3]; }
        ss = wsum(ss); const float rs = 1.0f / sqrtf(ss * (1.0f / 1024.0f) + 1e-6f);
#pragma unroll
        for (int j = 0; j < 4; ++j) { const f32x4 gg = *(const f32x4*)(g + j * 256 + lane * 4); const f32x4 y = v[j] * rs * gg;
            if (FINAL) *(f32x4*)(outf + (size_t)row * DM + j * 256 + lane * 4) = y;
            else { u32x2 w; w.x = pk(y[0], y[1]); w.y = pk(y[2], y[3]); *(u32x2*)(outb + (size_t)row * DM + j * 256 + lane * 4) = w; } }
    }
}

__device__ __forceinline__ void attn_phase(const bf16_t* P, const float* relb, bf16_t* mix, LAS unsigned char* lds) {
    const int tid = o_tid(), wid = tid >> 6, lane = tid & 63, r = lane & 15, q = lane >> 4, h = wid;
    LAS float* bias = (LAS float*)lds;
    LAS bf16_t* vt = (LAS bf16_t*)(lds + 8 * 260 * 4) + wid * (64 * 40);
    for (int i = tid; i < 8 * 257; i += 512) bias[(i / 257) * 260 + (i % 257)] = relb[i];
    __syncthreads();
    for (int item = o_bid(); item < 256; item += o_grid()) {
        const int b = item >> 6, n = item & 63; const int tok0 = b * SEQ + n * 64;
        bf16x8 Qf[4][2];
#pragma unroll
        for (int qb = 0; qb < 4; ++qb)
#pragma unroll
            for (int ks = 0; ks < 2; ++ks) Qf[qb][ks] = *(const bf16x8*)(P + (size_t)(tok0 + 16 * qb + r) * 3328 + h * 64 + 32 * ks + 8 * q);
        f32x4 O[4][4]; float mrun[4], lrun[4];
#pragma unroll
        for (int a = 0; a < 4; ++a) { mrun[a] = -1e30f; lrun[a] = 0.f;
#pragma unroll
            for (int c = 0; c < 4; ++c) O[a][c] = (f32x4){0.f, 0.f, 0.f, 0.f}; }
        const int jc0 = n >= 8 ? n - 8 : 0;
#pragma unroll 1
        for (int tile = jc0 * 2; tile < (n + 1) * 2; ++tile) {
            const int kp0 = tile * 32;
            const int kt0 = b * SEQ + kp0;
            { const int key = lane >> 1, d0 = (lane & 1) * 32; const bf16_t* vp = P + (size_t)(kt0 + key) * 3328 + 1024 + h * 64 + d0;
              u32x4 a[4];
#pragma unroll
              for (int i = 0; i < 4; ++i) a[i] = *(const u32x4*)(vp + 8 * i);
              __syncthreads();
#pragma unroll
              for (int i = 0; i < 4; ++i)
#pragma unroll
                  for (int e = 0; e < 4; ++e) { const unsigned wv = a[i][e]; vt[(d0 + 8 * i + 2 * e) * 40 + key] = (bf16_t)(wv & 0xffffu); vt[(d0 + 8 * i + 2 * e + 1) * 40 + key] = (bf16_t)(wv >> 16); }
              __syncthreads(); }
            bf16x8 Kf[2][2];
#pragma unroll
            for (int kb = 0; kb < 2; ++kb)
#pragma unroll
                for (int ks = 0; ks < 2; ++ks) Kf[kb][ks] = *(const bf16x8*)(P + (size_t)(kt0 + 16 * kb + r) * 3328 + 512 + h * 64 + 32 * ks + 8 * q);
            bf16x8 Pf[4];
#pragma unroll
            for (int qb = 0; qb < 4; ++qb) {
                f32x4 S[2];
#pragma unroll
                for (int kb = 0; kb < 2; ++kb) { S[kb] = (f32x4){0.f, 0.f, 0.f, 0.f};
                    S[kb] = __builtin_amdgcn_mfma_f32_16x16x32_bf16(Kf[kb][0], Qf[qb][0], S[kb], 0, 0, 0);
                    S[kb] = __builtin_amdgcn_mfma_f32_16x16x32_bf16(Kf[kb][1], Qf[qb][1], S[kb], 0, 0, 0); }
                const int qpos = n * 64 + 16 * qb + r; float mx = -1e30f;
#pragma unroll
                for (int kb = 0; kb < 2; ++kb)
#pragma unroll
                    for (int j = 0; j < 4; ++j) { const int dist = qpos - (kp0 + 16 * kb + 4 * q + j); const int idx = (dist < 128 ? dist : 128) + 128;
                        const float s = S[kb][j] * 0.125f + bias[h * 260 + idx]; S[kb][j] = s; mx = fmaxf(mx, s); }
                mx = fmaxf(mx, __shfl_xor(mx, 16)); mx = fmaxf(mx, __shfl_xor(mx, 32));
                const float mnew = fmaxf(mrun[qb], mx), alpha = __expf(mrun[qb] - mnew); mrun[qb] = mnew;
                float ps = 0.f; float pv[8];
#pragma unroll
                for (int kb = 0; kb < 2; ++kb)
#pragma unroll
                    for (int j = 0; j < 4; ++j) { const float e = __expf(S[kb][j] - mnew); pv[kb * 4 + j] = e; ps += e; }
                lrun[qb] = lrun[qb] * alpha + ps;
#pragma unroll
                for (int db = 0; db < 4; ++db) O[db][qb] = O[db][qb] * alpha;
                u32x4 w; w.x = pk(pv[0], pv[1]); w.y = pk(pv[2], pv[3]); w.z = pk(pv[4], pv[5]); w.w = pk(pv[6], pv[7]);
                Pf[qb] = __builtin_bit_cast(bf16x8, w);
            }
#pragma unroll
            for (int db = 0; db < 4; ++db) {
                const LAS bf16_t* vr = vt + (16 * db + r) * 40 + 4 * q;
                const u32x2 lo = *(const LAS u32x2*)vr, hi = *(const LAS u32x2*)(vr + 16);
                u32x4 w; w.x = lo.x; w.y = lo.y; w.z = hi.x; w.w = hi.y; const bf16x8 Vf = __builtin_bit_cast(bf16x8, w);
#pragma unroll
                for (int qb = 0; qb < 4; ++qb) O[db][qb] = __builtin_amdgcn_mfma_f32_16x16x32_bf16(Vf, Pf[qb], O[db][qb], 0, 0, 0);
            }
        }
#pragma unroll
        for (int qb = 0; qb < 4; ++qb) {
            float l = lrun[qb]; l += __shfl_xor(l, 16); l += __shfl_xor(l, 32); const float inv = 1.0f / l;
            bf16_t* op = mix + (size_t)(tok0 + 16 * qb + r) * 1024 + h * 64 + 4 * q;
#pragma unroll
            for (int db = 0; db < 4; ++db) { const f32x4 o = O[db][qb] * inv; u32x2 w; w.x = pk(o[0], o[1]); w.y = pk(o[2], o[3]); *(u32x2*)(op + 16 * db) = w; }
        }
    }
    __syncthreads();
}

__device__ __forceinline__ void prep_phase(const bf16_t* P, const float* mu, const float* k_k, float* rbuf, float* kbuf, float* kkbuf, bf16_t* vbuf, bf16_t* alora) {
    const int tid = o_tid();
    const float mu_r = mu[tid], mu_k = mu[512 + tid], mu_v = mu[1024 + tid], mu_t = tid < 256 ? mu[1536 + tid] : 0.f, kkw = k_k[tid];
    for (int item = o_bid(); item < 256; item += o_grid()) {
        const int tok0 = item * 64;
#pragma unroll 2
        for (int t = 0; t < 64; ++t) {
            const int tok = tok0 + t; const bool first = (tok & (SEQ - 1)) == 0;
            const bf16_t* pc = P + (size_t)tok * 3328 + 1536; const bf16_t* pp = first ? pc : pc - 3328;
            float c, pv;
            c = bf2f(pc[tid]); pv = first ? 0.f : bf2f(pp[tid]); rbuf[(size_t)tok * 512 + tid] = c + (pv - c) * mu_r;
            c = bf2f(pc[512 + tid]); pv = first ? 0.f : bf2f(pp[512 + tid]); const float ks = c + (pv - c) * mu_k; kbuf[(size_t)tok * 512 + tid] = ks;
            const float kkv = ks * kkw; const float ss = wsum(kkv * kkv); kkbuf[(size_t)tok * 512 + tid] = kkv * (1.0f / sqrtf(fmaxf(ss, 1e-24f)));
            c = bf2f(pc[1024 + tid]); pv = first ? 0.f : bf2f(pp[1024 + tid]); vbuf[(size_t)tok * 512 + tid] = f2bf(c + (pv - c) * mu_v);
            if (tid < 256) { c = bf2f(pc[1536 + tid]); pv = first ? 0.f : bf2f(pp[1536 + tid]); const float ts = c + (pv - c) * mu_t;
                const float o = tid < 64 ? tanhf(ts) : (tid < 128 ? ts : sigm(ts)); alora[(size_t)tok * 256 + tid] = f2bf(o); }
        }
    }
}

__device__ __forceinline__ void scan1_phase(const float* wb, const float* kkb, const float* kkab, const float* kb, const bf16_t* vb, float* Pm, float* Hm) {
    const int wid = __builtin_amdgcn_readfirstlane(o_tid() >> 6), lane = o_tid() & 63;
#pragma unroll 1
    for (int j = o_bid() * 8 + wid; j < 4096; j += o_grid() * 8) {
        const int bhc = j >> 1, which = j & 1, b = bhc >> 9, h = (bhc >> 6) & 7, c = bhc & 63;
        const size_t base0 = ((size_t)(b * SEQ + c * 64)) * 512 + h * 64;
        float s[64];
#pragma unroll
        for (int k = 0; k < 64; ++k) s[k] = (which == 0 && k == lane) ? 1.f : 0.f;
        if (which == 0) {
#pragma unroll 1
            for (int t = 0; t < 64; ++t) { const size_t base = base0 + (size_t)t * 512;
                cfp wp = (cfp)(wb + base), kkp = (cfp)(kkb + base), kap = (cfp)(kkab + base);
                float sa = 0.f;
#pragma unroll
                for (int k = 0; k < 64; ++k) sa = fmaf(s[k], kkp[k], sa);
                const float nsa = -sa;
#pragma unroll
                for (int k = 0; k < 64; ++k) s[k] = fmaf(s[k], wp[k], nsa * kap[k]); }
        } else {
#pragma unroll 1
            for (int t = 0; t < 64; ++t) { const size_t base = base0 + (size_t)t * 512;
                cfp wp = (cfp)(wb + base), kkp = (cfp)(kkb + base), kap = (cfp)(kkab + base), kp = (cfp)(kb + base);
                const float vv = bf2f(vb[base + lane]);
                float sa = 0.f;
#pragma unroll
                for (int k = 0; k < 64; ++k) sa = fmaf(s[k], kkp[k], sa);
                const float nsa = -sa;
#pragma unroll
                for (int k = 0; k < 64; ++k) s[k] = fmaf(s[k], wp[k], fmaf(nsa, kap[k], vv * kp[k])); }
        }
        float* dst = (which == 0 ? Pm : Hm) + (size_t)bhc * 4096 + lane * 64;
#pragma unroll
        for (int k4 = 0; k4 < 16; ++k4) *(f32x4*)(dst + 4 * k4) = (f32x4){s[4 * k4], s[4 * k4 + 1], s[4 * k4 + 2], s[4 * k4 + 3]};
    }
}
__device__ __forceinline__ void scan2_phase(const float* Pm, float* Hm, LAS float* lds) {
    const int tid = o_tid(), wid = tid >> 6, lane = tid & 63;
    for (int item = o_bid(); item < 256; item += o_grid()) {
        const int bh = item >> 3, rg = item & 7, v = rg * 8 + wid;
        const float* Pb = Pm + (size_t)bh * 64 * 4096; float* Hb = Hm + (size_t)bh * 64 * 4096 + v * 64 + lane;
        float s = 0.f;
        f32x4 pre0 = *(const f32x4*)(Pb + tid * 8), pre1 = *(const f32x4*)(Pb + tid * 8 + 4); float hn = Hb[0];
#pragma unroll 1
        for (int c = 0; c < 64; ++c) {
            LAS float* buf = lds + (c & 1) * 4096;
            *(LAS f32x4*)(buf + tid * 8) = pre0; *(LAS f32x4*)(buf + tid * 8 + 4) = pre1;
            const float hcur = hn;
            __syncthreads();
            if (c + 1 < 64) { pre0 = *(const f32x4*)(Pb + (size_t)(c + 1) * 4096 + tid * 8); pre1 = *(const f32x4*)(Pb + (size_t)(c + 1) * 4096 + tid * 8 + 4); hn = Hb[(size_t)(c + 1) * 4096]; }
            Hb[(size_t)c * 4096] = s;
            float acc = hcur; const int si = __float_as_int(s);
#pragma unroll
            for (int i = 0; i < 64; ++i) acc = fmaf(__int_as_float(__builtin_amdgcn_readlane(si, i)), buf[i * 64 + lane], acc);
            s = acc;
        }
        __syncthreads();
    }
}
__device__ __forceinline__ void scan3_phase(const float* rb, const float* wb, const float* kkb, const float* kkab, const float* kb, const bf16_t* vb, const bf16_t* gb, const float* Sinit,
                                            const float* ln_w, const float* ln_b, const float* r_k, bf16_t* mix, LAS float* lds) {
    const int wid = __builtin_amdgcn_readfirstlane(o_tid() >> 6), lane = o_tid() & 63;
    LAS float* ob = lds + wid * 4096;
#pragma unroll 1
    for (int bhc = o_bid() * 8 + wid; bhc < 2048; bhc += o_grid() * 8) {
        const int b = bhc >> 9, h = (bhc >> 6) & 7, c = bhc & 63;
        const size_t base0 = ((size_t)(b * SEQ + c * 64)) * 512 + h * 64;
        float s[64];
        { const float* sp = Sinit + (size_t)bhc * 4096 + lane * 64;
#pragma unroll
          for (int k4 = 0; k4 < 16; ++k4) { const f32x4 t4 = *(const f32x4*)(sp + 4 * k4); s[4 * k4] = t4[0]; s[4 * k4 + 1] = t4[1]; s[4 * k4 + 2] = t4[2]; s[4 * k4 + 3] = t4[3]; } }
#pragma unroll 1
        for (int t = 0; t < 64; ++t) { const size_t base = base0 + (size_t)t * 512;
            cfp wp = (cfp)(wb + base), kkp = (cfp)(kkb + base), kap = (cfp)(kkab + base), kp = (cfp)(kb + base), rp = (cfp)(rb + base);
            const float vv = bf2f(vb[base + lane]);
            float sa = 0.f;
#pragma unroll
            for (int k = 0; k < 64; ++k) sa = fmaf(s[k], kkp[k], sa);
            const float nsa = -sa; float o = 0.f;
#pragma unroll
            for (int k = 0; k < 64; ++k) { s[k] = fmaf(s[k], wp[k], fmaf(nsa, kap[k], vv * kp[k])); o = fmaf(s[k], rp[k], o); }
            ob[t * 64 + (lane ^ t)] = o; }
        { const int t = lane; const size_t tb = base0 + (size_t)t * 512; const LAS float* orow = ob + t * 64;
          float mean = 0.f;
#pragma unroll
          for (int v = 0; v < 64; ++v) mean += orow[v ^ t];
          mean *= (1.0f / 64.0f); float var = 0.f;
#pragma unroll
          for (int v = 0; v < 64; ++v) { const float d = orow[v ^ t] - mean; var = fmaf(d, d, var); }
          const float rstd = 1.0f / sqrtf(var * (1.0f / 64.0f) + 64e-5f);
          float bonus = 0.f;
#pragma unroll
          for (int k4 = 0; k4 < 16; ++k4) { const f32x4 rr = *(const f32x4*)(rb + tb + 4 * k4), kk4 = *(const f32x4*)(kb + tb + 4 * k4), rk = *(const f32x4*)(r_k + h * 64 + 4 * k4);
              bonus += rr[0] * kk4[0] * rk[0] + rr[1] * kk4[1] * rk[1] + rr[2] * kk4[2] * rk[2] + rr[3] * kk4[3] * rk[3]; }
          bf16_t* op = mix + (size_t)(b * SEQ + c * 64 + t) * 1024 + 512 + h * 64;
#pragma unroll
          for (int v8 = 0; v8 < 8; ++v8) { const u32x4 vw = *(const u32x4*)(vb + tb + 8 * v8), gw = *(const u32x4*)(gb + tb + 8 * v8); float o8[8];
#pragma unroll
              for (int e = 0; e < 8; ++e) { const int v = 8 * v8 + e; const unsigned vwe = vw[e >> 1], gwe = gw[e >> 1];
                  const float vvv = (e & 1) ? __uint_as_float(vwe & 0xffff0000u) : bf2f(vwe & 0xffffu), gg = (e & 1) ? __uint_as_float(gwe & 0xffff0000u) : bf2f(gwe & 0xffffu);
                  const float on = (orow[v ^ t] - mean) * rstd * ln_w[h * 64 + v] + ln_b[h * 64 + v]; o8[e] = (on + bonus * vvv) * gg; }
              u32x4 w; w.x = pk(o8[0], o8[1]); w.y = pk(o8[2], o8[3]); w.z = pk(o8[4], o8[5]); w.w = pk(o8[6], o8[7]); *(u32x4*)(op + 8 * v8) = w; }
        }
    }
}

__device__ __forceinline__ void conv_phase(const bf16_t* P2, const float* cw, const float* cb, float* xc, bf16_t* xcg) {
    const size_t total = (size_t)MT * 640;
    for (size_t e = (size_t)o_bid() * 512 + o_tid(); e < total; e += (size_t)o_grid() * 512) {
        const int tok = (int)(e / 640), ch = (int)(e % 640) * 2, tin = tok & (SEQ - 1);
        float a0 = cb[ch], a1 = cb[ch + 1];
#pragma unroll
        for (int j = 0; j < 4; ++j) { const int dt = 3 - j; if (tin >= dt) { const unsigned u = *(const unsigned*)(P2 + (size_t)(tok - dt) * 2560 + 1280 + ch);
            a0 = fmaf(cw[j * 1280 + ch], bf2f(u & 0xffffu), a0); a1 = fmaf(cw[j * 1280 + ch + 1], __uint_as_float(u & 0xffff0000u), a1); } }
        *(float2*)(xc + (size_t)tok * 1280 + ch) = make_float2(a0, a1);
        *(unsigned*)(xcg + ((size_t)(ch >> 8) * MT + tok) * 256 + (ch & 255)) = pk(a0, a1);
    }
}
__device__ __forceinline__ void cscan1_phase(const float* ab, const float* bb, float* sA, float* sH) {
    for (int e = o_bid() * 512 + o_tid(); e < 4 * 64 * 1280; e += o_grid() * 512) {
        const int ch = e % 1280, bc = e / 1280, b = bc >> 6, c = bc & 63; const size_t o0 = (size_t)(b * SEQ + c * 64) * 1280 + ch;
        float A = 1.f, hh = 0.f;
#pragma unroll 8
        for (int t = 0; t < 64; ++t) { const float av = ab[o0 + (size_t)t * 1280], bv = bb[o0 + (size_t)t * 1280]; hh = fmaf(av, hh, bv); A *= av; }
        sA[e] = A; sH[e] = hh;
    }
}
__device__ __forceinline__ void cscan2_phase(const float* ab, const float* bb, const float* sA, const float* sH, const bf16_t* P2, bf16_t* y) {
    for (int e = o_bid() * 512 + o_tid(); e < 4 * 64 * 1280; e += o_grid() * 512) {
        const int ch = e % 1280, bc = e / 1280, b = bc >> 6, c = bc & 63; const size_t tok0 = (size_t)(b * SEQ + c * 64);
        float hh = 0.f;
        for (int j = 0; j < c; ++j) { const int idx = (b * 64 + j) * 1280 + ch; hh = fmaf(hh, sA[idx], sH[idx]); }
#pragma unroll 8
        for (int t = 0; t < 64; ++t) { const size_t tok = tok0 + t; const float av = ab[tok * 1280 + ch], bv = bb[tok * 1280 + ch]; hh = fmaf(av, hh, bv);
            y[tok * 1280 + ch] = f2bf(hh * bf2f(P2[tok * 2560 + ch])); }
    }
}

constexpr int PH_PER_LAYER = 14, PH_TOTAL = 4 * PH_PER_LAYER + 1;
__host__ __device__ inline bool phase_skipped(int idx) { const int l = idx / PH_PER_LAYER, s = idx - l * PH_PER_LAYER; return idx < 4 * PH_PER_LAYER && (l & 1) && s == 9; }
__global__ __launch_bounds__(512, 2) void mega(Params p, int first, int last) {
    extern __shared__ __attribute__((aligned(16))) unsigned char shm[];
    LAS unsigned char* lds = (LAS unsigned char*)shm;
    for (int idx = first; idx < last; ++idx) {
        unsigned char* ws = p.ws; float* xo = p.out; asm volatile("" : "+s"(ws), "+s"(xo));
        bf16_t* hn = (bf16_t*)(ws + OFF_HN);
        const int l = idx / PH_PER_LAYER, s = idx - l * PH_PER_LAYER, odd = l & 1, i2 = l >> 1;
        if (phase_skipped(idx)) continue;
#if MODE_COOP
        if (idx > first) cg::this_grid().sync();
#endif
        if (idx == 4 * PH_PER_LAYER) { norm_phase<true>(xo, pin(p, I_NFIN), nullptr, xo); continue; }
        int ek = -1; pg8::Gemm g{nullptr, nullptr, MT, 0, 0};
        EpiResid er{nullptr, nullptr, 0.f}; EpiBf16Act eb{nullptr, 0, 0};
        const EvenMap em = even_map(i2); unsigned char* ar = ws + OFF_AR;
        if (s == 1 || s == 12) { ek = 0; g.A = hn; g.Bt = (const bf16_t*)(ws + OFF_WGU); g.N = 5632; g.K = 1024; }
        else if (s == 2 || s == 13) { ek = 1; g.A = (const bf16_t*)(ws + OFF_FF); g.Bt = (const bf16_t*)(ws + OFF_WD); g.N = 1024; g.K = 2816;
            er.src = (l == 0 && s == 2) ? pin(p, I_X) : xo; er.dst = xo; er.scale = 0.5f; }
        else if (s == 10) { ek = 1; g.N = 1024; er.src = xo; er.dst = xo; er.scale = 1.0f;
            if (!odd) { g.A = hn; g.Bt = (const bf16_t*)(ws + OFF_WOUT); g.K = 1024; } else { g.A = (const bf16_t*)(ws + OFF_XCG); g.Bt = (const bf16_t*)(ws + OFF_COUT); g.K = 1280; } }
        else if (s == 4) { ek = 2; g.A = hn; g.K = 1024;
            if (!odd) { g.Bt = (const bf16_t*)(ws + OFF_WIN); g.N = 3328; eb.O = (bf16_t*)(ar + em.P); eb.ldc = 3328; eb.gelu_tiles = 0; }
            else { g.Bt = (const bf16_t*)(ws + OFF_CIN); g.N = 2560; eb.O = (bf16_t*)(ws + OFF_P2); eb.ldc = 2560; eb.gelu_tiles = 5; } }
        if (ek >= 0) {
            pg8::StaticOrder S; S.init(g.M, g.N, o_grid(), o_bid());
            if (ek == 0) { EpiSwiglu E{(bf16_t*)(ws + OFF_FF)}; pg8::gemm_phase<EpiSwiglu, pg8::StaticOrder, false>(lds, g, S, E, nullptr); }
            else if (ek == 1) pg8::gemm_phase<EpiResid, pg8::StaticOrder, false>(lds, g, S, er, nullptr);
            else pg8::gemm_phase<EpiBf16Act, pg8::StaticOrder, false>(lds, g, S, eb, nullptr);
            continue;
        }
        if (s == 0 || s == 11) { const float* src = (l == 0 && s == 0) ? pin(p, I_X) : xo; norm_phase<false>(src, pin(p, I_NFFN) + (size_t)(l * 2 + (s == 11)) * 1024, hn, nullptr);
            convert_ffn(p, l, s == 11, (LAS float*)lds); continue; }
        if (s == 3) { norm_phase<false>(xo, pin(p, I_NMIX) + (size_t)l * 1024, hn, nullptr); convert_mixer(p, l, (LAS float*)lds); continue; }
        if (!odd) {
            float* rbuf = (float*)(ar + em.r); float* kbuf = (float*)(ar + em.k); float* kkbuf = (float*)(ar + em.kk); float* wbuf = (float*)(ar + em.w); float* kkabuf = (float*)(ar + em.kka);
            bf16_t* gbuf = (bf16_t*)(ar + em.g); bf16_t* vfirst = (bf16_t*)(ws + OFF_VF); bf16_t* vsh = (bf16_t*)(ar + em.vsh); bf16_t* v2 = (bf16_t*)(ar + em.v2); bf16_t* alora = (bf16_t*)(ar + em.al);
            const bf16_t* vscan = i2 == 0 ? vfirst : v2; const bf16_t* Pb = (const bf16_t*)(ar + em.P);
            float* Pm = (float*)(ar + em.pm); float* Hm = (float*)(ar + em.hm);
            if (s == 5) {
                attn_phase(Pb, pin(p, I_RELB) + (size_t)i2 * 8 * 257, hn, lds);
                prep_phase(Pb, pin(p, I_MU) + (size_t)i2 * 1792, pin(p, I_KK) + (size_t)i2 * 512, rbuf, kbuf, kkbuf, i2 == 0 ? vfirst : vsh, alora);
            } else if (s == 6) {
                { pg8::Gemm gl{alora, (const bf16_t*)(ws + OFF_WLORA), MT, 1536, 256}; pg8::StaticOrder S; S.init(MT, 1536, o_grid(), o_bid());
                  EpiLora E{wbuf, kbuf, kkbuf, kkabuf, gbuf, pin(p, I_W0) + (size_t)i2 * 512, pin(p, I_A0) + (size_t)i2 * 512, pin(p, I_KA) + (size_t)i2 * 512};
                  pg8::gemm_phase<EpiLora, pg8::StaticOrder, false>(lds, gl, S, E, nullptr); }
                if (i2 == 1) { pg8::Gemm gv{vsh, (const bf16_t*)(ws + OFF_WV), MT, 512, 512}; pg8::StaticOrder S; S.init(MT, 512, o_grid(), o_bid());
                  EpiVLora E{vsh, vfirst, v2, pin(p, I_V0)};
                  pg8::gemm_phase<EpiVLora, pg8::StaticOrder, false>(lds, gv, S, E, nullptr); }
            } else if (s == 7) scan1_phase(wbuf, kkbuf, kkabuf, kbuf, vscan, Pm, Hm);
            else if (s == 8) scan2_phase(Pm, Hm, (LAS float*)lds);
            else if (s == 9) scan3_phase(rbuf, wbuf, kkbuf, kkabuf, kbuf, vscan, gbuf, Hm, pin(p, I_LNW) + (size_t)i2 * 512, pin(p, I_LNB) + (size_t)i2 * 512, pin(p, I_RK) + (size_t)i2 * 512, hn, (LAS float*)lds);
        } else {
            const bf16_t* P2 = (const bf16_t*)(ws + OFF_P2); float* xc = (float*)(ws + OFF_XC); bf16_t* xcg = (bf16_t*)(ws + OFF_XCG); float* ab = (float*)(ws + OFF_A);
            float* sA = (float*)(ws + OFF_SA); float* sH = (float*)(ws + OFF_SH);
            if (s == 5) conv_phase(P2, pin(p, I_CCW) + (size_t)i2 * 4 * 1280, pin(p, I_CCB) + (size_t)i2 * 1280, xc, xcg);
            else if (s == 6) { pg8::Gemm gg{xcg, (const bf16_t*)(ws + OFF_WGATES), 5 * MT, 2560, 256}; GatesOrder S{o_grid(), o_bid()};
                EpiGates E{xc, ab, pin(p, I_CBA) + (size_t)i2 * 1280, pin(p, I_CBX) + (size_t)i2 * 1280, pin(p, I_LAM) + (size_t)i2 * 1280};
                pg8::gemm_phase<EpiGates, GatesOrder, false>(lds, gg, S, E, nullptr); }
            else if (s == 7) cscan1_phase(ab, xc, sA, sH);
            else if (s == 8) cscan2_phase(ab, xc, sA, sH, P2, xcg);
        }
    }
}

extern "C" void kernel_launch(void* const* d_in, const int* in_sizes, int n_in, void* d_out, int out_size, void* d_ws, size_t ws_size, hipStream_t stream) {
    static int grid = 0;
    if (grid == 0) {
        if (n_in != 33 || out_size != MT * DM || ws_size < WS_NEED) { fprintf(stderr, "kernel_launch: unexpected shapes (n_in %d, out %d, ws %zu, need %zu)\n", n_in, out_size, ws_size, (size_t)WS_NEED); grid = -1; return; }
        int dev = 0, cus = 0, per_cu = 0;
        hipGetDevice(&dev); hipDeviceGetAttribute(&cus, hipDeviceAttributeMultiprocessorCount, dev);
        if (hipFuncSetAttribute((const void*)mega, hipFuncAttributeMaxDynamicSharedMemorySize, LDS_BYTES) != hipSuccess) { fprintf(stderr, "kernel_launch: hipFuncSetAttribute failed\n"); grid = -1; return; }
        if (hipOccupancyMaxActiveBlocksPerMultiprocessor(&per_cu, (const void*)mega, 512, LDS_BYTES) != hipSuccess || per_cu < 1) { fprintf(stderr, "kernel_launch: occupancy query says %d\n", per_cu); per_cu = 1; }
        (void)hipGetLastError();
        grid = cus * (per_cu > 1 ? 1 : per_cu); if (grid > 256) grid = 256;
    }
    if (grid < 0) return;
    Params p{}; for (int i = 0; i < 33; ++i) p.in[i] = (const float*)d_in[i];
    p.out = (float*)d_out; p.ws = (unsigned char*)d_ws;
#if MODE_COOP
    int first = 0, last = PH_TOTAL; void* args[] = {&p, &first, &last};
    hipError_t e = hipLaunchCooperativeKernel((const void*)mega, dim3(grid), dim3(512), args, LDS_BYTES, stream);
    if (e != hipSuccess) fprintf(stderr, "cooperative launch failed: %s (grid %d)\n", hipGetErrorString(e), grid);
#else
    for (int idx = 0; idx < PH_TOTAL; ++idx) {
        if (phase_skipped(idx)) continue;
        hipLaunchKernelGGL(mega, dim3(grid), dim3(512), LDS_BYTES, stream, p, idx, idx + 1);
    }
#endif
}
```

```cpp
#include <hip/hip_runtime.h>
#include <hip/hip_cooperative_groups.h>
#include <cstdio>
namespace cg = cooperative_groups;
#ifndef MODE_COOP
#define MODE_COOP 1
#endif
__device__ __forceinline__ int o_tid() { int t = threadIdx.x; asm volatile("" : "+v"(t)); return t; }
__device__ __forceinline__ int o_bid() { int t = blockIdx.x; asm volatile("" : "+s"(t)); return t; }
__device__ __forceinline__ int o_grid() { int t = gridDim.x; asm volatile("" : "+s"(t)); return t; }
namespace pg8 {
#define PG8_LAS __attribute__((address_space(3)))
typedef unsigned short bf16_t;
typedef short bf16x8 __attribute__((ext_vector_type(8)));
typedef float f32x4 __attribute__((ext_vector_type(4)));
typedef unsigned u32x4 __attribute__((ext_vector_type(4)));
constexpr int BM = 256, BK = 64, HALF = 128, HTB = HALF * BK * 2  , STAGE_BYTES = 8 * HTB, NXCD = 8, WGM = 8;

__host__ __device__ __forceinline__ int lds_byte(int r, int c) { const int st = (r >> 4) * 2 + (c >> 5), rr = r & 15, cc = c & 31, ob = rr * 64 + cc * 2; return st * 1024 + (ob ^ (((ob >> 9) & 1) << 5)); }
__host__ __device__ __forceinline__ void stage_rc(int b, int& R, int& C) { const int st = b / 1024, sb = b % 1024, swz = sb ^ (((sb >> 9) & 1) << 5); R = (st >> 1) * 16 + swz / 64; C = (st & 1) * 32 + (swz % 64) / 2; }
__host__ __device__ __forceinline__ int perm32(int rho) { const int n = rho >> 4, i = rho & 15; return 8 * (i >> 2) + 4 * n + (i & 3); }

struct Unit { int pm, pn; };
struct Gemm { const bf16_t* A; const bf16_t* Bt; int M, N, K; };

struct StaticOrder {
    int nM, nN, nwg, G, c;
    __host__ __device__ void init(int M, int N, int G_, int c_) { nM = M / BM; nN = N / BM; nwg = nM * nN; G = G_; c = c_; }
    __host__ __device__ bool next(int i, Unit& u) const {
        const long L = (long)i * G + c; if (L >= nwg) return false;
        int wgid = (int)L; { const int q = nwg / NXCD, r = nwg % NXCD, xcd = wgid % NXCD, off = wgid / NXCD; wgid = (xcd < r ? xcd * (q + 1) : r * (q + 1) + (xcd - r) * q) + off; }
        const int nig = WGM * nN, gid = wgid / nig, fm = gid * WGM, gsz = (nM - fm) < WGM ? (nM - fm) : WGM;
        u.pm = fm + ((wgid % nig) % gsz); u.pn = (wgid % nig) / gsz; return true;
    }
    __device__ __forceinline__ void a_ready(const Unit&) const {}
    __device__ __forceinline__ void done(const Unit&) const {}
};
__device__ __forceinline__ unsigned cvt_pk_bf16(float lo, float hi) { unsigned r; asm volatile("v_cvt_pk_bf16_f32 %0, %1, %2" : "=v"(r) : "v"(lo), "v"(hi)); return r; }
typedef float f32x2 __attribute__((ext_vector_type(2)));
template <class Epi, class Sched, bool STAMP = false>
__device__ __forceinline__ void gemm_phase(PG8_LAS unsigned char* lds, const Gemm g, const Sched& S, const Epi& E, unsigned long long* stamps) {
    const int tid = o_tid(), wid = __builtin_amdgcn_readfirstlane(tid >> 6), lane = tid & 63, wr = wid >> 2, wc = wid & 3, fr = lane & 15, fq = lane >> 4;
    int Kq_ = g.K; asm volatile("" : "+s"(Kq_)); const int K = Kq_, nt = K / BK;
    int ts_lo = 0, ts_hi = 0, nts = 0; const unsigned long long rt_entry = STAMP ? (unsigned long long)wall_clock64() : 0ull;
#define PG8_STAMP() do { if (STAMP && wid == 0 && nts < 64) { const unsigned long long _c = (unsigned long long)clock64(); \
        ts_lo = (lane == nts) ? (int)(unsigned)_c : ts_lo; ts_hi = (lane == nts) ? (int)(unsigned)(_c >> 32) : ts_hi; ++nts; } } while (0)
    PG8_STAMP();
    unsigned voffA[2], voffB[2];
#pragma unroll
    for (int i = 0; i < 2; ++i) { int R, C; stage_rc(tid * 16 + i * 8192, R, C); const int Rb = Epi::PERM ? ((R & ~31) + perm32(R & 31)) : R;
        voffA[i] = (unsigned)(R * K + C) * 2u; voffB[i] = (unsigned)(Rb * K + C) * 2u; }
    const size_t kstep = (size_t)(BK * 2);
    const size_t hstep = (size_t)HALF * K * 2;
    const size_t tstep = 2 * hstep;
    const unsigned ldsw = (unsigned)wid * 1024u;
    const int aoff = lds_byte(wr * 64 + fr, fq * 8), boff = lds_byte(wc * 32 + fr, fq * 8);
#define PG8_SA(b, h) (((b) * 2 + (h)) * HTB)
#define PG8_SB(b, h) ((4 + (b) * 2 + (h)) * HTB)
#define PG8_STAGE(bufoff, gbase, voff) do { _Pragma("unroll") for (int _i = 0; _i < 2; ++_i) \
        __builtin_amdgcn_global_load_lds((const unsigned*)((const char*)(gbase) + (voff)[_i]), (PG8_LAS unsigned*)(lds + (bufoff) + ldsw + _i * 8192), 16, 0, 0); } while (0)
#define PG8_LDA(dst, b, h) do { _Pragma("unroll") for (int m = 0; m < 4; ++m) _Pragma("unroll") for (int k = 0; k < 2; ++k) dst[m][k] = *(const PG8_LAS bf16x8*)(lds + PG8_SA(b, h) + aoff + m * 2048 + k * 1024); } while (0)
#define PG8_LDB(dst, b, h) do { _Pragma("unroll") for (int n = 0; n < 2; ++n) _Pragma("unroll") for (int k = 0; k < 2; ++k) dst[n][k] = *(const PG8_LAS bf16x8*)(lds + PG8_SB(b, h) + boff + n * 2048 + k * 1024); } while (0)
#define PG8_MMA(ai, bj, At, Bt) do { __builtin_amdgcn_s_setprio(1); _Pragma("unroll") for (int m = 0; m < 4; ++m) _Pragma("unroll") for (int n = 0; n < 2; ++n) _Pragma("unroll") for (int k = 0; k < 2; ++k) \
        acc[ai][bj][m][n] = __builtin_amdgcn_mfma_f32_16x16x32_bf16(Bt[n][k], At[m][k], acc[ai][bj][m][n], 0, 0, 0); __builtin_amdgcn_s_setprio(0); } while (0)
#define PG8_WAIT_V(n) asm volatile("s_waitcnt vmcnt(" #n ")" ::: "memory")
#define PG8_WAIT_L(n) asm volatile("s_waitcnt lgkmcnt(" #n ")" ::: "memory")
#define PG8_BAR __builtin_amdgcn_s_barrier()
#define PG8_SCHED __builtin_amdgcn_sched_barrier(0)
    Unit cur, nxt; int ui = 0;
    if (!S.next(0, cur)) return;
    f32x4 acc[2][2][4][2];
#pragma unroll
    for (int a = 0; a < 2; ++a)
#pragma unroll
        for (int b = 0; b < 2; ++b)
#pragma unroll
            for (int m = 0; m < 4; ++m)
#pragma unroll
                for (int n = 0; n < 2; ++n) acc[a][b][m][n] = (f32x4){0.f, 0.f, 0.f, 0.f};
    bf16x8 At[4][2], B0[2][2], B1[2][2];
    const char* cA = (const char*)g.A + (size_t)cur.pm * tstep; const char* cB = (const char*)g.Bt + (size_t)cur.pn * tstep;
    S.a_ready(cur);
    PG8_STAGE(PG8_SB(0, 0), cB, voffB); PG8_STAGE(PG8_SA(0, 0), cA, voffA); PG8_STAGE(PG8_SB(0, 1), cB + hstep, voffB); PG8_STAGE(PG8_SA(0, 1), cA + hstep, voffA);
    if (wr == 1) PG8_BAR;
    PG8_WAIT_V(4); PG8_BAR;
    PG8_STAGE(PG8_SB(1, 0), cB + kstep, voffB); PG8_STAGE(PG8_SA(1, 0), cA + kstep, voffA); PG8_STAGE(PG8_SB(1, 1), cB + hstep + kstep, voffB);
    PG8_WAIT_V(6); PG8_BAR;
    PG8_STAMP();
    for (;;) {
        const bool has_next = S.next(ui + 1, nxt);
        const char* nA = has_next ? (const char*)g.A + (size_t)nxt.pm * tstep : cA; const char* nB = has_next ? (const char*)g.Bt + (size_t)nxt.pn * tstep : cB;
        for (int t = 0; t < nt; t += 2) {
            const bool last = (t == nt - 2);
            const char* a1 = cA + (size_t)(t + 1) * kstep;
            const char* a2 = last ? nA : cA + (size_t)(t + 2) * kstep; const char* b2 = last ? nB : cB + (size_t)(t + 2) * kstep;
            const char* a3 = a2 + kstep; const char* b3 = b2 + kstep;
            if (last && has_next) S.a_ready(nxt);
            PG8_LDB(B0, 0, 0); PG8_SCHED; PG8_LDA(At, 0, 0); PG8_STAGE(PG8_SA(1, 1), a1 + hstep, voffA);
            PG8_WAIT_L(8); PG8_BAR; PG8_WAIT_L(0); PG8_MMA(0, 0, At, B0); PG8_BAR; PG8_SCHED;
            PG8_LDB(B1, 0, 1); PG8_STAGE(PG8_SB(0, 0), b2, voffB);
            PG8_BAR; PG8_WAIT_L(0); PG8_MMA(0, 1, At, B1); PG8_BAR;
            PG8_LDA(At, 0, 1); PG8_STAGE(PG8_SA(0, 0), a2, voffA);
            PG8_BAR; PG8_WAIT_L(0); PG8_MMA(1, 0, At, B0); PG8_BAR; PG8_SCHED;
            PG8_STAGE(PG8_SB(0, 1), b2 + hstep, voffB);
            PG8_WAIT_V(6); PG8_BAR; PG8_MMA(1, 1, At, B1); PG8_BAR;
            PG8_LDB(B0, 1, 0); PG8_SCHED; PG8_LDA(At, 1, 0); PG8_STAGE(PG8_SA(0, 1), a2 + hstep, voffA);
            PG8_WAIT_L(8); PG8_BAR; PG8_WAIT_L(0); PG8_MMA(0, 0, At, B0); PG8_BAR; PG8_SCHED;
            PG8_LDB(B1, 1, 1); PG8_STAGE(PG8_SB(1, 0), b3, voffB);
            PG8_BAR; PG8_WAIT_L(0); PG8_MMA(0, 1, At, B1); PG8_BAR;
            PG8_LDA(At, 1, 1); PG8_STAGE(PG8_SA(1, 0), a3, voffA);
            PG8_BAR; PG8_WAIT_L(0); PG8_MMA(1, 0, At, B0); PG8_BAR; PG8_SCHED;
            PG8_STAGE(PG8_SB(1, 1), b3 + hstep, voffB);
            PG8_WAIT_V(6); PG8_BAR; PG8_MMA(1, 1, At, B1); PG8_BAR;
        }
        PG8_STAMP();
        if constexpr (!Epi::AFTER_DRAIN) { E(acc, cur, wr, wc, fr, fq); S.done(cur); }
        PG8_STAMP();
        if (!has_next) break;
#pragma unroll
        for (int a = 0; a < 2; ++a)
#pragma unroll
            for (int b = 0; b < 2; ++b)
#pragma unroll
                for (int m = 0; m < 4; ++m)
#pragma unroll
                    for (int n = 0; n < 2; ++n) acc[a][b][m][n] = (f32x4){0.f, 0.f, 0.f, 0.f};
        cur = nxt; cA = nA; cB = nB; ++ui;
    }
    PG8_WAIT_V(0);
    if (wr == 0) PG8_BAR;
    PG8_BAR;
    if constexpr (Epi::AFTER_DRAIN) { E.fused(acc, cur, wr, wc, fr, fq, lds, wid, lane); S.done(cur); }
    PG8_STAMP();
    if (STAMP && wid == 0) { stamps[lane] = lane < nts ? (((unsigned long long)(unsigned)ts_hi << 32) | (unsigned)ts_lo) : 0ull;
        if (lane == 62) stamps[62] = rt_entry; if (lane == 63) stamps[63] = (unsigned long long)wall_clock64(); }
#undef PG8_STAMP
#undef PG8_SA
#undef PG8_SB
#undef PG8_STAGE
#undef PG8_LDA
#undef PG8_LDB
#undef PG8_MMA
#undef PG8_WAIT_V
#undef PG8_WAIT_L
#undef PG8_BAR
#undef PG8_SCHED
}
}

using pg8::bf16_t; using pg8::bf16x8; using pg8::f32x4; using pg8::u32x4; using pg8::Unit; using pg8::BM; using pg8::HALF;
typedef unsigned u32x2 __attribute__((ext_vector_type(2)));
#define LAS __attribute__((address_space(3)))
#define GAS __attribute__((address_space(1)))

constexpr int MT = 16384, SEQ = 4096, DM = 1024, DFF = 2816;
constexpr int LDS_BYTES = 131072 + 2048;

constexpr size_t SZ_WGU = 5632ull * 1024 * 2, SZ_WD = 1024ull * 2816 * 2;
constexpr size_t OFF_WA = 0, END_WA = OFF_WA + SZ_WGU + SZ_WD;
constexpr size_t OFF_WB = END_WA;
constexpr size_t OFF_WIN = OFF_WB, OFF_WOUT = OFF_WIN + 3328ull * 1024 * 2, OFF_WLORA = OFF_WOUT + 1024ull * 1024 * 2, OFF_WV = OFF_WLORA + 1536ull * 256 * 2, END_WEVEN = OFF_WV + 512ull * 512 * 2;
constexpr size_t OFF_CIN = OFF_WB, OFF_COUT = OFF_CIN + 2560ull * 1024 * 2, OFF_WGATES = OFF_COUT + 1024ull * 1280 * 2, END_WODD = OFF_WGATES + 2560ull * 256 * 2;
constexpr size_t OFF_XB = END_WEVEN > END_WODD ? END_WEVEN : END_WODD;
constexpr size_t OFF_VF = OFF_XB + (size_t)MT * 1024 * 2;
constexpr size_t OFF_SS = OFF_VF + (size_t)MT * 512 * 2;
constexpr size_t OFF_AR = OFF_SS + 13ull * MT * 4;
constexpr size_t SLOT = (size_t)MT * 512 * 4, SZ_B512 = (size_t)MT * 512 * 2;
constexpr size_t OFF_FF = OFF_AR;
constexpr size_t OFF_W9 = OFF_AR + 9 * SLOT;
struct EvenMap { size_t w, kka, r, k, kk, P, vsh, al, g, v2, pm, hm, si; };
__device__ __forceinline__ EvenMap even_map(int) {
    EvenMap m; m.w = 0; m.kka = SLOT; m.r = 2 * SLOT; m.k = 3 * SLOT; m.kk = 4 * SLOT; m.P = 5 * SLOT; m.vsh = 8 * SLOT + SLOT / 4; m.al = 8 * SLOT + 3 * SLOT / 4; m.g = 5 * SLOT; m.v2 = 5 * SLOT + SLOT / 2;
    m.pm = 6 * SLOT; m.hm = 7 * SLOT; m.si = 4 * SLOT;
    return m; }
static_assert((size_t)MT * 3328 * 2 <= 3 * SLOT + SLOT / 4, "P fits 3.25 slots");
constexpr size_t OFF_P2 = OFF_AR;
constexpr size_t OFF_XC = OFF_P2 + (size_t)MT * 2560 * 2;
constexpr size_t OFF_XCG = OFF_XC + (size_t)MT * 1280 * 4;
constexpr size_t OFF_A = OFF_XCG + (size_t)MT * 1280 * 2;
constexpr size_t OFF_SA = OFF_A + (size_t)MT * 1280 * 4, OFF_SH = OFF_SA + 4ull * 64 * 1280 * 4, END_ODD = OFF_SH + 4ull * 64 * 1280 * 4;
constexpr size_t OFF_BAR = OFF_AR + 10 * SLOT;
constexpr size_t WS_NEED = OFF_BAR + 16384;
static_assert(END_ODD <= OFF_W9, "odd map");
static_assert(WS_NEED <= 415039552ull, "workspace map larger than the guaranteed minimum (sum of the inputs)");

struct Params { const float* in[33]; float* out; unsigned char* ws; };
enum { I_X = 0, I_NFFN, I_WG, I_WU, I_WDN, I_NMIX, I_ABIN, I_ABOUT, I_RELB, I_MU, I_W0, I_WUP, I_A0, I_AUP, I_GUP, I_KK, I_KA, I_RK, I_LNW, I_LNB, I_V0, I_VDN, I_VUP,
       I_CIN, I_CCW, I_CCB, I_CWA, I_CBA, I_CWX, I_CBX, I_LAM, I_COUT, I_NFIN };

__device__ __forceinline__ const float* pin(const Params& p, int i) { asm volatile("" : "+s"(i)); const float* r = p.in[i]; const GAS float* q; asm volatile("" : "=s"(q) : "0"(r)); return (const float*)q; }
__device__ __forceinline__ float bf2f(unsigned u16) { return __uint_as_float(u16 << 16); }
__device__ __forceinline__ unsigned pk(float a, float b) { return pg8::cvt_pk_bf16(a, b); }
__device__ __forceinline__ bf16_t f2bf(float a) { return (bf16_t)(pg8::cvt_pk_bf16(a, 0.f) & 0xffffu); }
__device__ __forceinline__ float sigm(float x) { return __builtin_amdgcn_rcpf(1.0f + __expf(-x)); }
__device__ __forceinline__ float wsum(float v) {
#pragma unroll
    for (int o = 32; o >= 1; o >>= 1) v += __shfl_xor(v, o);
    return v; }

__device__ __forceinline__ void unpack8(const u32x4 w, float (&f)[8]) {
#pragma unroll
    for (int e = 0; e < 4; ++e) { f[2 * e] = bf2f(w[e] & 0xffffu); f[2 * e + 1] = __uint_as_float(w[e] & 0xffff0000u); } }
__device__ __forceinline__ u32x4 pack8(const float (&f)[8]) { u32x4 w; w.x = pk(f[0], f[1]); w.y = pk(f[2], f[3]); w.z = pk(f[4], f[5]); w.w = pk(f[6], f[7]); return w; }
__device__ __forceinline__ float rs_of(unsigned s) { return 1.0f / sqrtf((float)s * (1.0f / (1024.0f * 1024.0f)) + 1e-6f); }
__device__ __forceinline__ void row_scales(float (&rs)[2][4], const unsigned* ss, const LAS float* rtab, int pm, int row0, int rloc) {
    if (((const LAS int*)rtab)[256] == pm) {
#pragma unroll
        for (int ai = 0; ai < 2; ++ai)
#pragma unroll
            for (int m = 0; m < 4; ++m) rs[ai][m] = rtab[rloc + ai * HALF + m * 16];
    } else { unsigned sv[2][4];
#pragma unroll
        for (int ai = 0; ai < 2; ++ai)
#pragma unroll
            for (int m = 0; m < 4; ++m) sv[ai][m] = ss[row0 + ai * HALF + m * 16];
#pragma unroll
        for (int ai = 0; ai < 2; ++ai)
#pragma unroll
            for (int m = 0; m < 4; ++m) rs[ai][m] = rs_of(sv[ai][m]); }
}
__device__ __forceinline__ void fill_row_scales(LAS float* rtab, const unsigned* ss, int pm) {
    if (threadIdx.x < 256) rtab[threadIdx.x] = rs_of(ss[pm * BM + threadIdx.x]);
    if (threadIdx.x == 0) ((LAS int*)rtab)[256] = pm;
    __syncthreads();
}
struct EpiSwiglu {
    static constexpr bool PERM = true, AFTER_DRAIN = false;
    bf16_t* O; const unsigned* ss; const LAS float* rtab;
    __device__ __forceinline__ void operator()(const f32x4 (&acc)[2][2][4][2], const Unit& u, int wr, int wc, int fr, int fq) const {
        const int row0 = u.pm * BM + wr * 64 + fr, col0 = u.pn * 128 + wc * 32 + 8 * fq;
        float rs[2][4]; row_scales(rs, ss, rtab, u.pm, row0, wr * 64 + fr);
#pragma unroll
        for (int ai = 0; ai < 2; ++ai)
#pragma unroll
            for (int m = 0; m < 4; ++m) {
                bf16_t* rowp = O + (size_t)(row0 + ai * HALF + m * 16) * DFF + col0;
                float hv[8];
#pragma unroll
                for (int n = 0; n < 2; ++n)
#pragma unroll
                    for (int j = 0; j < 4; ++j) { const float g = acc[ai][0][m][n][j] * rs[ai][m], uu = acc[ai][1][m][n][j] * rs[ai][m]; hv[n * 4 + j] = g * sigm(g) * uu; }
                u32x4 w; w.x = pk(hv[0], hv[1]); w.y = pk(hv[2], hv[3]); w.z = pk(hv[4], hv[5]); w.w = pk(hv[6], hv[7]);
                *(u32x4*)rowp = w;
            }
    }
};
struct ResidDesc { const float* src; float* dst; bf16_t* xb; unsigned* ss; float scale; int pad; };
struct EpiResid {
    static constexpr bool PERM = true, AFTER_DRAIN = false;
    const LAS ResidDesc* d;
    __device__ __forceinline__ void operator()(const f32x4 (&acc)[2][2][4][2], const Unit& u, int wr, int wc, int fr, int fq) const {
        const float* src; float* dst; bf16_t* xb; unsigned* ss; const float scale = d->scale;
        { const float* s0 = d->src; float* d0 = d->dst; bf16_t* x0 = d->xb; unsigned* q0 = d->ss; const GAS float* s1; GAS float* d1; GAS bf16_t* x1; GAS unsigned* q1;
          asm volatile("" : "=v"(s1), "=v"(d1), "=v"(x1), "=v"(q1) : "0"(s0), "1"(d0), "2"(x0), "3"(q0)); src = (const float*)s1; dst = (float*)d1; xb = (bf16_t*)x1; ss = (unsigned*)q1; }
        const int row0 = u.pm * BM + wr * 64 + fr, col0 = u.pn * BM + wc * 32 + 8 * fq;
        float sq[8]; f32x4 cur[4], nxt[4];
        { const size_t off = (size_t)row0 * DM + col0;
#pragma unroll
          for (int bj = 0; bj < 2; ++bj) { cur[2 * bj] = *(const f32x4*)(src + off + bj * HALF); cur[2 * bj + 1] = *(const f32x4*)(src + off + bj * HALF + 4); } }
#pragma unroll
        for (int gi = 0; gi < 8; ++gi) { const int ai = gi >> 2, m = gi & 3;
            const size_t off = (size_t)(row0 + ai * HALF + m * 16) * DM + col0;
            if (gi + 1 < 8) { const size_t offn = (size_t)(row0 + ((gi + 1) >> 2) * HALF + ((gi + 1) & 3) * 16) * DM + col0;
#pragma unroll
                for (int bj = 0; bj < 2; ++bj) { nxt[2 * bj] = *(const f32x4*)(src + offn + bj * HALF); nxt[2 * bj + 1] = *(const f32x4*)(src + offn + bj * HALF + 4); } }
            float q = 0.f;
#pragma unroll
            for (int bj = 0; bj < 2; ++bj) { const f32x4 v0 = cur[2 * bj] + acc[ai][bj][m][0] * scale, v1 = cur[2 * bj + 1] + acc[ai][bj][m][1] * scale;
                *(f32x4*)(dst + off + bj * HALF) = v0; *(f32x4*)(dst + off + bj * HALF + 4) = v1;
                u32x4 w; w.x = pk(v0[0], v0[1]); w.y = pk(v0[2], v0[3]); w.z = pk(v1[0], v1[1]); w.w = pk(v1[2], v1[3]); *(u32x4*)(xb + off + bj * HALF) = w;
                q += v0[0] * v0[0] + v0[1] * v0[1] + v0[2] * v0[2] + v0[3] * v0[3] + v1[0] * v1[0] + v1[1] * v1[1] + v1[2] * v1[2] + v1[3] * v1[3]; }
            sq[gi] = q;
#pragma unroll
            for (int i = 0; i < 4; ++i) cur[i] = nxt[i]; }
#pragma unroll
        for (int gi = 0; gi < 8; ++gi) { float q = sq[gi]; q += __shfl_xor(q, 16); q += __shfl_xor(q, 32);
            if (fq == 0) __hip_atomic_fetch_add(ss + row0 + (gi >> 2) * HALF + (gi & 3) * 16, (unsigned)(q * 1024.0f + 0.5f), __ATOMIC_RELAXED, __HIP_MEMORY_SCOPE_AGENT); }
    }
};
__device__ __forceinline__ float gelu_tanh(float x) { const float u2 = 1.5957691216f * (x + 0.044715f * x * x * x); return x * sigm(u2); }
struct EpiBf16Act {
    static constexpr bool PERM = true, AFTER_DRAIN = false;
    bf16_t* O; int ldc; int gelu_tiles; const unsigned* ss; const LAS float* rtab;
    __device__ __forceinline__ void operator()(const f32x4 (&acc)[2][2][4][2], const Unit& u, int wr, int wc, int fr, int fq) const {
        const int row0 = u.pm * BM + wr * 64 + fr, col0 = u.pn * BM + wc * 32 + 8 * fq; const bool act = u.pn < gelu_tiles;
        float rsv[2][4]; row_scales(rsv, ss, rtab, u.pm, row0, wr * 64 + fr);
#pragma unroll
        for (int ai = 0; ai < 2; ++ai)
#pragma unroll
            for (int m = 0; m < 4; ++m) {
                bf16_t* rowp = O + (size_t)(row0 + ai * HALF + m * 16) * ldc + col0;
                const float rs = rsv[ai][m];
#pragma unroll
                for (int bj = 0; bj < 2; ++bj) {
                    f32x4 v0 = acc[ai][bj][m][0] * rs, v1 = acc[ai][bj][m][1] * rs;
                    if (act) {
#pragma unroll
                        for (int j = 0; j < 4; ++j) { v0[j] = gelu_tanh(v0[j]); v1[j] = gelu_tanh(v1[j]); } }
                    u32x4 w; w.x = pk(v0[0], v0[1]); w.y = pk(v0[2], v0[3]); w.z = pk(v1[0], v1[1]); w.w = pk(v1[2], v1[3]);
                    *(u32x4*)(rowp + bj * HALF) = w;
                }
            }
    }
};
struct EpiLora {
    static constexpr bool PERM = true, AFTER_DRAIN = false;
    float* wbuf; float* kkabuf; bf16_t* gbuf; const float* w0; const float* a0;
    __device__ __forceinline__ void operator()(const f32x4 (&acc)[2][2][4][2], const Unit& u, int wr, int wc, int fr, int fq) const {
        const int row0 = u.pm * BM + wr * 64 + fr, seg = u.pn >> 1, cl0 = (u.pn & 1) * 256 + wc * 32 + 8 * fq;
        if (seg < 2) {
            const float* bp = (seg == 0 ? w0 : a0) + cl0; float* dst = seg == 0 ? wbuf : kkabuf;
            f32x4 bv[2][2];
#pragma unroll
            for (int bj = 0; bj < 2; ++bj)
#pragma unroll
                for (int n = 0; n < 2; ++n) bv[bj][n] = *(const f32x4*)(bp + bj * HALF + 4 * n);
#pragma unroll
            for (int ai = 0; ai < 2; ++ai)
#pragma unroll
                for (int m = 0; m < 4; ++m) { float* rowp = dst + (size_t)(row0 + ai * HALF + m * 16) * 512 + cl0;
#pragma unroll
                    for (int bj = 0; bj < 2; ++bj)
#pragma unroll
                        for (int n = 0; n < 2; ++n) { f32x4 o;
#pragma unroll
                            for (int j = 0; j < 4; ++j) { const float sg = sigm(bv[bj][n][j] + acc[ai][bj][m][n][j]); o[j] = seg == 0 ? __expf(-0.606531f * sg) : sg; }
                            *(f32x4*)(rowp + bj * HALF + 4 * n) = o; } }
        } else {
#pragma unroll
            for (int ai = 0; ai < 2; ++ai)
#pragma unroll
                for (int m = 0; m < 4; ++m) { const size_t off = (size_t)(row0 + ai * HALF + m * 16) * 512 + cl0;
#pragma unroll
                    for (int bj = 0; bj < 2; ++bj) { const f32x4 v0 = acc[ai][bj][m][0], v1 = acc[ai][bj][m][1];
                        u32x4 w; w.x = pk(v0[0], v0[1]); w.y = pk(v0[2], v0[3]); w.z = pk(v1[0], v1[1]); w.w = pk(v1[2], v1[3]); *(u32x4*)(gbuf + off + bj * HALF) = w; } }
        }
    }
};
struct EpiVLora {
    static constexpr bool PERM = true, AFTER_DRAIN = false;
    const bf16_t* vsh; const bf16_t* vfirst; bf16_t* v2; const float* v0;
    __device__ __forceinline__ void operator()(const f32x4 (&acc)[2][2][4][2], const Unit& u, int wr, int wc, int fr, int fq) const {
        const int row0 = u.pm * BM + wr * 64 + fr, cl0 = u.pn * BM + wc * 32 + 8 * fq;
        f32x4 bv[2][2];
#pragma unroll
        for (int bj = 0; bj < 2; ++bj)
#pragma unroll
            for (int n = 0; n < 2; ++n) bv[bj][n] = *(const f32x4*)(v0 + cl0 + bj * HALF + 4 * n);
#pragma unroll
        for (int ai = 0; ai < 2; ++ai)
#pragma unroll
            for (int bj = 0; bj < 2; ++bj) {
                u32x4 av[4], fv[4];
#pragma unroll
                for (int m = 0; m < 4; ++m) { const size_t off = (size_t)(row0 + ai * HALF + m * 16) * 512 + cl0 + bj * HALF; av[m] = *(const u32x4*)(vsh + off); fv[m] = *(const u32x4*)(vfirst + off); }
#pragma unroll
                for (int m = 0; m < 4; ++m) { const size_t off = (size_t)(row0 + ai * HALF + m * 16) * 512 + cl0 + bj * HALF; float a8[8], f8[8], o8[8]; unpack8(av[m], a8); unpack8(fv[m], f8);
#pragma unroll
                    for (int e = 0; e < 8; ++e) o8[e] = a8[e] + (f8[e] - a8[e]) * sigm(bv[bj][e >> 2][e & 3] + acc[ai][bj][m][e >> 2][e & 3]);
                    *(u32x4*)(v2 + off) = pack8(o8); }
                __builtin_amdgcn_sched_barrier(0); }
    }
};
struct EpiGates {
    static constexpr bool PERM = true, AFTER_DRAIN = false;
    const bf16_t* xcg; float* bbuf; float* abuf; const float* ba; const float* bx; const float* lam;
    __device__ __forceinline__ void operator()(const f32x4 (&acc)[2][2][4][2], const Unit& u, int wr, int wc, int fr, int fq) const {
        const int row0 = (u.pm & 63) * BM + wr * 64 + fr, ch0 = u.pn * 128 + wc * 32 + 8 * fq;
        const bf16_t* xsrc = xcg + ((size_t)(ch0 >> 8) * MT) * 256 + (ch0 & 255);
        f32x4 bav[2], bxv[2], sp[2];
#pragma unroll
        for (int n = 0; n < 2; ++n) { bav[n] = *(const f32x4*)(ba + ch0 + 4 * n); bxv[n] = *(const f32x4*)(bx + ch0 + 4 * n); const f32x4 lv = *(const f32x4*)(lam + ch0 + 4 * n);
#pragma unroll
            for (int j = 0; j < 4; ++j) { const float y = __expf(-lv[j]);
                const float l1p = y < 0.02f ? y * (1.0f + y * (-0.5f + y * (0.33333333f + y * (-0.25f + y * 0.2f)))) : __logf(1.0f + y); sp[n][j] = -8.0f * l1p; } }
#pragma unroll
        for (int ai = 0; ai < 2; ++ai) {
            u32x4 xw[4];
#pragma unroll
            for (int m = 0; m < 4; ++m) xw[m] = *(const u32x4*)(xsrc + (size_t)(row0 + ai * HALF + m * 16) * 256);
#pragma unroll
            for (int m = 0; m < 4; ++m) { const size_t off = (size_t)(row0 + ai * HALF + m * 16) * 1280 + ch0; float xc[8]; unpack8(xw[m], xc);
#pragma unroll
                for (int n = 0; n < 2; ++n) { f32x4 ao, bo;
#pragma unroll
                    for (int j = 0; j < 4; ++j) { const float r = sigm(acc[ai][0][m][n][j] + bav[n][j]), ig = sigm(acc[ai][1][m][n][j] + bxv[n][j]); const float la = sp[n][j] * r, x2 = 2.0f * la;
                        ao[j] = __expf(la);
                        const float em = x2 > -0.25f ? -x2 * (1.0f + x2 * (0.5f + x2 * (0.16666667f + x2 * (0.041666668f + x2 * (0.0083333338f + x2 * (0.0013888889f + x2 * 0.0001984127f)))))) : 1.0f - __expf(x2);
                        bo[j] = sqrtf(fmaxf(em, 0.0f)) * ig * xc[4 * n + j]; }
                    *(f32x4*)(abuf + off + 4 * n) = ao; *(f32x4*)(bbuf + off + 4 * n) = bo; } }
            __builtin_amdgcn_sched_barrier(0); }
    }
};
struct GatesOrder {
    int G, c;
    __device__ __forceinline__ bool next(int i, Unit& u) const { const int L = i * G + c; if (L >= 640) return false; const int g = L >> 7, rem = L & 127; u.pm = g * 64 + (rem >> 1); u.pn = g * 2 + (rem & 1); return true; }
    __device__ __forceinline__ void a_ready(const Unit&) const {}
    __device__ __forceinline__ void done(const Unit&) const {}
};

__device__ __forceinline__ void transpose_job(const float* src, int K, int N, bf16_t* dst, int mode, LAS float* tile, const float* gvec) {
    const int tid = o_tid(), tn_cnt = N >> 6, ntiles = (K >> 6) * tn_cnt, G = o_grid();
    const int r = tid >> 4, c4 = (tid & 15) * 4, n = tid >> 3, ks = (tid & 7) * 8;
    int t = o_bid(); if (t >= ntiles) return;
    f32x4 cur[2], nxt[2];
    { const int tk = t / tn_cnt, tn = t - tk * tn_cnt;
#pragma unroll
      for (int h = 0; h < 2; ++h) cur[h] = *(const f32x4*)(src + (size_t)(tk * 64 + r + 32 * h) * N + tn * 64 + c4); }
#pragma unroll 1
    for (; t < ntiles; t += G) {
        const int tk = t / tn_cnt, tn = t - tk * tn_cnt, k0 = tk * 64, n0 = tn * 64;
        const int t2 = t + G;
        if (t2 < ntiles) { const int tk2 = t2 / tn_cnt, tn2 = t2 - tk2 * tn_cnt;
#pragma unroll
            for (int h = 0; h < 2; ++h) nxt[h] = *(const f32x4*)(src + (size_t)(tk2 * 64 + r + 32 * h) * N + tn2 * 64 + c4); }
#pragma unroll
        for (int h = 0; h < 2; ++h) { LAS float* d = tile + (r + 32 * h) * 65 + c4; d[0] = cur[h][0]; d[1] = cur[h][1]; d[2] = cur[h][2]; d[3] = cur[h][3]; }
        __syncthreads();
        { float v[8];
#pragma unroll
          for (int i = 0; i < 8; ++i) v[i] = tile[(ks + i) * 65 + n];
          if (gvec) { const f32x4 g0 = *(const f32x4*)(gvec + k0 + ks), g1 = *(const f32x4*)(gvec + k0 + ks + 4);
#pragma unroll
              for (int i = 0; i < 4; ++i) { v[i] *= g0[i]; v[4 + i] *= g1[i]; } }
          const int gn = n0 + n; const int R = mode == 0 ? gn : ((gn >> 7) * 256 + (gn & 127) + (mode == 2 ? 128 : 0));
          u32x4 w; w.x = pk(v[0], v[1]); w.y = pk(v[2], v[3]); w.z = pk(v[4], v[5]); w.w = pk(v[6], v[7]);
          *(u32x4*)(dst + (size_t)R * K + k0 + ks) = w; }
        __syncthreads();
        cur[0] = nxt[0]; cur[1] = nxt[1];
    }
}
__device__ __forceinline__ void convert_ffn(const Params& p, int l, int s, bf16_t* gu, bf16_t* dn, LAS float* tile) {
    const size_t wo = (size_t)(l * 2 + s) * 1024 * 2816; const float* gv = pin(p, I_NFFN) + (size_t)(l * 2 + s) * 1024;
    transpose_job(pin(p, I_WG) + wo, 1024, 2816, gu, 1, tile, gv);
    transpose_job(pin(p, I_WU) + wo, 1024, 2816, gu, 2, tile, gv);
    transpose_job(pin(p, I_WDN) + wo, 2816, 1024, dn, 0, tile, nullptr);
}
__device__ __forceinline__ void convert_mixer(const Params& p, int l, LAS float* tile) {
    unsigned char* ws = p.ws; const int i2 = l >> 1;
    const int gtid = o_bid() * 512 + o_tid(), gsz = o_grid() * 512;
    if ((l & 1) == 0) {
        transpose_job(pin(p, I_ABIN) + (size_t)i2 * 1024 * 3328, 1024, 3328, (bf16_t*)(ws + OFF_WIN), 0, tile, pin(p, I_NMIX) + (size_t)l * 1024);
        transpose_job(pin(p, I_ABOUT) + (size_t)i2 * 1024 * 1024, 1024, 1024, (bf16_t*)(ws + OFF_WOUT), 0, tile, nullptr);
        const float* wup = pin(p, I_WUP) + (size_t)i2 * 64 * 512; const float* aup = pin(p, I_AUP) + (size_t)i2 * 64 * 512; const float* gup = pin(p, I_GUP) + (size_t)i2 * 128 * 512;
        bf16_t* wl = (bf16_t*)(ws + OFF_WLORA);
        for (int e = gtid; e < 1536 * 256; e += gsz) { const int R = e >> 8, kk = e & 255, seg = R >> 9, c = R & 511; float v = 0.f;
            if (seg == 0) { if (kk < 64) v = wup[kk * 512 + c]; } else if (seg == 1) { if (kk >= 64 && kk < 128) v = aup[(kk - 64) * 512 + c]; } else { if (kk >= 128) v = gup[(kk - 128) * 512 + c]; }
            wl[e] = f2bf(v); }
        if (i2 == 1) { const float* vd = pin(p, I_VDN); const float* vu = pin(p, I_VUP); bf16_t* wv = (bf16_t*)(ws + OFF_WV);
            for (int e = gtid; e < 512 * 512; e += gsz) { const int n = e >> 9, k = e & 511; float a = 0.f;
#pragma unroll 8
                for (int j = 0; j < 32; ++j) a = fmaf(vd[k * 32 + j], vu[j * 512 + n], a);
                wv[e] = f2bf(a); } }
    } else {
        transpose_job(pin(p, I_CIN) + (size_t)i2 * 1024 * 2560, 1024, 2560, (bf16_t*)(ws + OFF_CIN), 0, tile, pin(p, I_NMIX) + (size_t)l * 1024);
        transpose_job(pin(p, I_COUT) + (size_t)i2 * 1280 * 1024, 1280, 1024, (bf16_t*)(ws + OFF_COUT), 0, tile, nullptr);
        const float* wa = pin(p, I_CWA) + (size_t)i2 * 10 * 128 * 128; const float* wx = pin(p, I_CWX) + (size_t)i2 * 10 * 128 * 128; bf16_t* wg = (bf16_t*)(ws + OFF_WGATES);
        for (int e = gtid; e < 2560 * 256; e += gsz) { const int R = e >> 8, kk = e & 255, pn = R >> 8, bj = (R >> 7) & 1, d = R & 127; float v = 0.f;
            if ((kk >> 7) == (pn & 1)) v = (bj ? wx : wa)[((size_t)pn * 128 + (kk & 127)) * 128 + d];
            wg[e] = f2bf(v); }
    }
}

__device__ __forceinline__ void prologue_phase(const float* x, bf16_t* xb, unsigned* ss) {
    const int wid = o_tid() >> 6, lane = o_tid() & 63;
    for (int i = o_bid() * 512 + o_tid(); i < 12 * MT; i += o_grid() * 512) ss[MT + i] = 0u;
#pragma unroll 1
    for (int row = (o_bid() * 8 + wid) * 2; row < MT; row += o_grid() * 16) {
        f32x4 v[2][4]; float sq[2] = {0.f, 0.f};
#pragma unroll
        for (int rr = 0; rr < 2; ++rr)
#pragma unroll
            for (int j = 0; j < 4; ++j) v[rr][j] = *(const f32x4*)(x + (size_t)(row + rr) * DM + j * 256 + lane * 4);
#pragma unroll
        for (int rr = 0; rr < 2; ++rr)
#pragma unroll
            for (int j = 0; j < 4; ++j) { sq[rr] += v[rr][j][0] * v[rr][j][0] + v[rr][j][1] * v[rr][j][1] + v[rr][j][2] * v[rr][j][2] + v[rr][j][3] * v[rr][j][3];
                u32x2 w; w.x = pk(v[rr][j][0], v[rr][j][1]); w.y = pk(v[rr][j][2], v[rr][j][3]); *(u32x2*)(xb + (size_t)(row + rr) * DM + j * 256 + lane * 4) = w; }
#pragma unroll
        for (int o = 32; o >= 1; o >>= 1) { sq[0] += __shfl_xor(sq[0], o); sq[1] += __shfl_xor(sq[1], o); }
        if (lane == 0) { ss[row] = (unsigned)(sq[0] * 1024.0f + 0.5f); ss[row + 1] = (unsigned)(sq[1] * 1024.0f + 0.5f); }
    }
}
template <bool FINAL> __device__ __forceinline__ void norm_phase(const float* x, const float* g, bf16_t* outb, float* outf) {
    const int wid = o_tid() >> 6, lane = o_tid() & 63;
    f32x4 gg[4];
#pragma unroll
    for (int j = 0; j < 4; ++j) gg[j] = *(const f32x4*)(g + j * 256 + lane * 4);
#pragma unroll 1
    for (int row = (o_bid() * 8 + wid) * 2; row < MT; row += o_grid() * 16) {
        f32x4 v[2][4]; float ss[2] = {0.f, 0.f};
#pragma unroll
        for (int rr = 0; rr < 2; ++rr)
#pragma unroll
            for (int j = 0; j < 4; ++j) v[rr][j] = *(const f32x4*)(x + (size_t)(row + rr) * DM + j * 256 + lane * 4);
#pragma unroll
        for (int rr = 0; rr < 2; ++rr) {
#pragma unroll
            for (int j = 0; j < 4; ++j) ss[rr] += v[rr][j][0] * v[rr][j][0] + v[rr][j][1] * v[rr][j][1] + v[rr][j][2] * v[rr][j][2] + v[rr][j][3] * v[rr][j][3]; }
#pragma unroll
        for (int o = 32; o >= 1; o >>= 1) { ss[0] += __shfl_xor(ss[0], o); ss[1] += __shfl_xor(ss[1], o); }
#pragma unroll
        for (int rr = 0; rr < 2; ++rr) { const float rs = 1.0f / sqrtf(ss[rr] * (1.0f / 1024.0f) + 1e-6f);
#pragma unroll
            for (int j = 0; j < 4; ++j) { const f32x4 y = v[rr][j] * rs * gg[j];
                if (FINAL) *(f32x4*)(outf + (size_t)(row + rr) * DM + j * 256 + lane * 4) = y;
                else { u32x2 w; w.x = pk(y[0], y[1]); w.y = pk(y[2], y[3]); *(u32x2*)(outb + (size_t)(row + rr) * DM + j * 256 + lane * 4) = w; } } }
    }
}

__device__ __forceinline__ float xrow16_max(float x) {
    auto s = __builtin_amdgcn_permlane16_swap(__float_as_uint(x), __float_as_uint(x), false, false);
    x = fmaxf(__uint_as_float(s[0]), __uint_as_float(s[1]));
    auto t = __builtin_amdgcn_permlane32_swap(__float_as_uint(x), __float_as_uint(x), false, false);
    return fmaxf(__uint_as_float(t[0]), __uint_as_float(t[1]));
}
__device__ __forceinline__ float xrow16_sum(float x) {
    auto s = __builtin_amdgcn_permlane16_swap(__float_as_uint(x), __float_as_uint(x), false, false);
    x = __uint_as_float(s[0]) + __uint_as_float(s[1]);
    auto t = __builtin_amdgcn_permlane32_swap(__float_as_uint(x), __float_as_uint(x), false, false);
    return __uint_as_float(t[0]) + __uint_as_float(t[1]);
}
__device__ __forceinline__ void attn_phase(const bf16_t* P, const float* relb, bf16_t* mix, LAS unsigned char* lds) {
    const int tid = o_tid(), wid = tid >> 6, lane = tid & 63, r = lane & 15, q = lane >> 4, h = wid;
    LAS float* bias = (LAS float*)lds;
    LAS bf16_t* vt = (LAS bf16_t*)(lds + 8 * 260 * 4) + wid * (64 * 40);
    for (int i = tid; i < 8 * 257; i += 512) bias[(i / 257) * 260 + (i % 257)] = relb[i];
    __syncthreads();
    const float bfar = bias[h * 260 + 256];
    for (int item = o_bid(); item < 256; item += o_grid()) {
        const int it = (item & 7) * 32 + (item >> 3);
        const int b = it >> 6, n = it & 63; const int tok0 = b * SEQ + n * 64;
        bf16x8 Qf[4][2];
#pragma unroll
        for (int qb = 0; qb < 4; ++qb)
#pragma unroll
            for (int ks = 0; ks < 2; ++ks) Qf[qb][ks] = *(const bf16x8*)(P + (size_t)(tok0 + 16 * qb + r) * 3328 + h * 64 + 32 * ks + 8 * q);
        f32x4 O[4][4]; float mrun[4], lrun[4];
#pragma unroll
        for (int a = 0; a < 4; ++a) { mrun[a] = -1e30f; lrun[a] = 0.f;
#pragma unroll
            for (int c = 0; c < 4; ++c) O[a][c] = (f32x4){0.f, 0.f, 0.f, 0.f}; }
        const int jc0 = n >= 8 ? n - 8 : 0, tile_end = (n + 1) * 2;
        const int vkey = lane >> 1, vd0 = (lane & 1) * 32;
        bf16x8 K0[2][2], K1[2][2]; u32x4 V0[4];
        auto fetchK = [&](int tile, bf16x8 (&Kd)[2][2]) {
            const int kt = b * SEQ + tile * 32;
#pragma unroll
            for (int kb = 0; kb < 2; ++kb)
#pragma unroll
                for (int ks = 0; ks < 2; ++ks) Kd[kb][ks] = *(const bf16x8*)(P + (size_t)(kt + 16 * kb + r) * 3328 + 512 + h * 64 + 32 * ks + 8 * q); };
        auto fetchV = [&](int tile) {
            const bf16_t* vp = P + (size_t)(b * SEQ + tile * 32 + vkey) * 3328 + 1024 + h * 64 + vd0;
#pragma unroll
            for (int i = 0; i < 4; ++i) V0[i] = *(const u32x4*)(vp + 8 * i); };
        fetchK(jc0 * 2, K0); fetchK(jc0 * 2 + 1, K1); fetchV(jc0 * 2);
#pragma unroll 1
        for (int tile = jc0 * 2; tile < tile_end; ++tile) {
            const int kp0 = tile * 32;
            const bool far = kp0 + 31 + 128 <= n * 64;
            bf16x8 Pf[4];
#pragma unroll
            for (int qb = 0; qb < 4; ++qb) {
                f32x4 S[2];
#pragma unroll
                for (int kb = 0; kb < 2; ++kb) { S[kb] = (f32x4){0.f, 0.f, 0.f, 0.f};
                    S[kb] = __builtin_amdgcn_mfma_f32_16x16x32_bf16(K0[kb][0], Qf[qb][0], S[kb], 0, 0, 0);
                    S[kb] = __builtin_amdgcn_mfma_f32_16x16x32_bf16(K0[kb][1], Qf[qb][1], S[kb], 0, 0, 0); }
                const int qpos = n * 64 + 16 * qb + r; float mx = -1e30f;
                if (far) {
#pragma unroll
                    for (int kb = 0; kb < 2; ++kb)
#pragma unroll
                        for (int j = 0; j < 4; ++j) { const float sv = fmaf(S[kb][j], 0.125f, bfar); S[kb][j] = sv; mx = fmaxf(mx, sv); }
                } else {
#pragma unroll
                    for (int kb = 0; kb < 2; ++kb)
#pragma unroll
                        for (int j = 0; j < 4; ++j) { const int dist = qpos - (kp0 + 16 * kb + 4 * q + j); const int idx = (dist < 128 ? dist : 128) + 128;
                            const float sv = fmaf(S[kb][j], 0.125f, bias[h * 260 + idx]); S[kb][j] = sv; mx = fmaxf(mx, sv); }
                }
                mx = xrow16_max(mx);
                const float mnew = fmaxf(mrun[qb], mx), alpha = __expf(mrun[qb] - mnew); mrun[qb] = mnew;
                float ps = 0.f; float pv[8];
#pragma unroll
                for (int kb = 0; kb < 2; ++kb)
#pragma unroll
                    for (int j = 0; j < 4; ++j) { const float e = __expf(S[kb][j] - mnew); pv[kb * 4 + j] = e; ps += e; }
                lrun[qb] = lrun[qb] * alpha + ps;
#pragma unroll
                for (int db = 0; db < 4; ++db) O[db][qb] = O[db][qb] * alpha;
                u32x4 w; w.x = pk(pv[0], pv[1]); w.y = pk(pv[2], pv[3]); w.z = pk(pv[4], pv[5]); w.w = pk(pv[6], pv[7]);
                Pf[qb] = __builtin_bit_cast(bf16x8, w);
            }
#pragma unroll
            for (int kb = 0; kb < 2; ++kb)
#pragma unroll
                for (int ks = 0; ks < 2; ++ks) K0[kb][ks] = K1[kb][ks];
            if (tile + 2 < tile_end) fetchK(tile + 2, K1);
            __builtin_amdgcn_wave_barrier();
#pragma unroll
            for (int i = 0; i < 4; ++i)
#pragma unroll
                for (int e = 0; e < 4; ++e) { const unsigned wv = V0[i][e]; vt[(vd0 + 8 * i + 2 * e) * 40 + vkey] = (bf16_t)(wv & 0xffffu); vt[(vd0 + 8 * i + 2 * e + 1) * 40 + vkey] = (bf16_t)(wv >> 16); }
            __builtin_amdgcn_wave_barrier();
            if (tile + 1 < tile_end) fetchV(tile + 1);
#pragma unroll
            for (int db = 0; db < 4; ++db) {
                const LAS bf16_t* vr = vt + (16 * db + r) * 40 + 4 * q;
                const u32x2 lo = *(const LAS u32x2*)vr, hi = *(const LAS u32x2*)(vr + 16);
                u32x4 w; w.x = lo.x; w.y = lo.y; w.z = hi.x; w.w = hi.y; const bf16x8 Vf = __builtin_bit_cast(bf16x8, w);
#pragma unroll
                for (int qb = 0; qb < 4; ++qb) O[db][qb] = __builtin_amdgcn_mfma_f32_16x16x32_bf16(Vf, Pf[qb], O[db][qb], 0, 0, 0);
            }
        }
#pragma unroll
        for (int qb = 0; qb < 4; ++qb) {
            const float l = xrow16_sum(lrun[qb]); const float inv = 1.0f / l;
            bf16_t* op = mix + (size_t)(tok0 + 16 * qb + r) * 1024 + h * 64 + 4 * q;
#pragma unroll
            for (int db = 0; db < 4; ++db) { const f32x4 o = O[db][qb] * inv; u32x2 w; w.x = pk(o[0], o[1]); w.y = pk(o[2], o[3]); *(u32x2*)(op + 16 * db) = w; }
        }
    }
    __syncthreads();
}

__device__ __forceinline__ void prep_phase(const bf16_t* P, const float* mu, const float* k_k, float* rbuf, float* kbuf, float* kkbuf, bf16_t* vbuf, bf16_t* alora) {
    const int tid = o_tid(), wid = tid >> 6, lane = tid & 63, c0 = lane * 8;
    float mur[8], muk[8], muv[8], mut[8], kkw[8];
#pragma unroll
    for (int e = 0; e < 8; ++e) { mur[e] = mu[c0 + e]; muk[e] = mu[512 + c0 + e]; muv[e] = mu[1024 + c0 + e]; mut[e] = lane < 32 ? mu[1536 + c0 + e] : 0.f; kkw[e] = k_k[c0 + e]; }
#pragma unroll 1
    for (int tok = o_bid() * 8 + wid; tok < MT; tok += o_grid() * 8) {
        const bool first = (tok & (SEQ - 1)) == 0;
        const bf16_t* pc = P + (size_t)tok * 3328 + 1536 + c0; const bf16_t* pp = first ? pc : pc - 3328;
        const u32x4 z = {0u, 0u, 0u, 0u};
        const u32x4 cr = *(const u32x4*)pc, ck = *(const u32x4*)(pc + 512), cv = *(const u32x4*)(pc + 1024), ct = lane < 32 ? *(const u32x4*)(pc + 1536) : z;
        u32x4 qr = *(const u32x4*)pp, qk = *(const u32x4*)(pp + 512), qv = *(const u32x4*)(pp + 1024), qt = lane < 32 ? *(const u32x4*)(pp + 1536) : z;
        if (first) { qr = z; qk = z; qv = z; qt = z; }
        float c[8], pv[8], o[8];
        unpack8(cr, c); unpack8(qr, pv);
#pragma unroll
        for (int e = 0; e < 8; ++e) o[e] = c[e] + (pv[e] - c[e]) * mur[e];
        { float* d = rbuf + (size_t)tok * 512 + c0; *(f32x4*)d = (f32x4){o[0], o[1], o[2], o[3]}; *(f32x4*)(d + 4) = (f32x4){o[4], o[5], o[6], o[7]}; }
        unpack8(ck, c); unpack8(qk, pv); float ss = 0.f;
#pragma unroll
        for (int e = 0; e < 8; ++e) { o[e] = c[e] + (pv[e] - c[e]) * muk[e]; const float kv = o[e] * kkw[e]; ss = fmaf(kv, kv, ss); }
        { float* d = kbuf + (size_t)tok * 512 + c0; *(f32x4*)d = (f32x4){o[0], o[1], o[2], o[3]}; *(f32x4*)(d + 4) = (f32x4){o[4], o[5], o[6], o[7]}; }
        ss += __shfl_xor(ss, 1); ss += __shfl_xor(ss, 2); ss += __shfl_xor(ss, 4);
        const float rn = 1.0f / sqrtf(fmaxf(ss, 1e-24f));
        { float* d = kkbuf + (size_t)tok * 512 + c0; *(f32x4*)d = (f32x4){o[0] * kkw[0] * rn, o[1] * kkw[1] * rn, o[2] * kkw[2] * rn, o[3] * kkw[3] * rn};
          *(f32x4*)(d + 4) = (f32x4){o[4] * kkw[4] * rn, o[5] * kkw[5] * rn, o[6] * kkw[6] * rn, o[7] * kkw[7] * rn}; }
        unpack8(cv, c); unpack8(qv, pv);
#pragma unroll
        for (int e = 0; e < 8; ++e) o[e] = c[e] + (pv[e] - c[e]) * muv[e];
        *(u32x4*)(vbuf + (size_t)tok * 512 + c0) = pack8(o);
        if (lane < 32) { unpack8(ct, c); unpack8(qt, pv);
#pragma unroll
            for (int e = 0; e < 8; ++e) { const float ts = c[e] + (pv[e] - c[e]) * mut[e]; o[e] = lane < 8 ? (2.0f * sigm(2.0f * ts) - 1.0f) : (lane < 16 ? ts : sigm(ts)); }
            *(u32x4*)(alora + (size_t)tok * 256 + c0) = pack8(o); }
    }
}

#define RL(x, k) __int_as_float(__builtin_amdgcn_readlane((x), (k)))
__device__ __forceinline__ void scan1_phase(float* wb, const float* kkb, float* kkab, float* kb, const float* rb, const bf16_t* vb, const float* k_a, const float* r_k, float* Pm, float* Hm) {
    const int wid = __builtin_amdgcn_readfirstlane(o_tid() >> 6), lane = o_tid() & 63;
#pragma unroll 1
    for (int bhc = o_bid() * 8 + wid; bhc < 2048; bhc += o_grid() * 8) {
        const int b = bhc >> 9, h = (bhc >> 6) & 7, c = bhc & 63;
        const size_t base0 = ((size_t)(b * SEQ + c * 64)) * 512 + h * 64 + lane;
        const float kav = k_a[h * 64 + lane], rkv = r_k[h * 64 + lane];
        float sP[64], sH[64];
#pragma unroll
        for (int k = 0; k < 64; ++k) { sP[k] = (k == lane) ? 1.f : 0.f; sH[k] = 0.f; }
        float nw = wb[base0], nkk = kkb[base0], nr = rb[base0], nv = bf2f(vb[base0]), nka, nk;
        { const float a = kkab[base0], ks = kb[base0]; nka = nkk * a; nk = ks * (1.0f + (a - 1.0f) * kav); }
#pragma unroll 1
        for (int t = 0; t < 64; ++t) { const size_t base = base0 + (size_t)t * 512;
            const int iw = __float_as_int(nw), ikk = __float_as_int(nkk), ika = __float_as_int(nka), ik = __float_as_int(nk), ir = __float_as_int(nr); const float vv = nv, pr = nr * nk * rkv;
            if (t + 1 < 64) { const size_t o = base + 512; nw = wb[o]; nkk = kkb[o]; nr = rb[o]; nv = bf2f(vb[o]); const float a = kkab[o], ks = kb[o]; nka = nkk * a; nk = ks * (1.0f + (a - 1.0f) * kav); }
            pg8::f32x2 aP2 = {0.f, 0.f}, aH2 = {0.f, 0.f};
#pragma unroll
            for (int k = 0; k < 64; k += 2) { const pg8::f32x2 kk2 = {RL(ikk, k), RL(ikk, k + 1)};
                aP2 = __builtin_elementwise_fma((pg8::f32x2){sP[k], sP[k + 1]}, kk2, aP2); aH2 = __builtin_elementwise_fma((pg8::f32x2){sH[k], sH[k + 1]}, kk2, aH2); }
            const float nP = -(aP2.x + aP2.y), nH = -(aH2.x + aH2.y);
            pg8::f32x2 q2 = {0.f, 0.f}, l2 = {0.f, 0.f};
#pragma unroll
            for (int k = 0; k < 64; k += 2) {
                const pg8::f32x2 w2 = {RL(iw, k), RL(iw, k + 1)}, ka2 = {RL(ika, k), RL(ika, k + 1)}, k2 = {RL(ik, k), RL(ik, k + 1)}, r2 = {RL(ir, k), RL(ir, k + 1)};
                pg8::f32x2 p2 = {sP[k], sP[k + 1]}, h2 = {sH[k], sH[k + 1]};
                p2 = __builtin_elementwise_fma(p2, w2, ka2 * nP);
                h2 = __builtin_elementwise_fma(h2, w2, __builtin_elementwise_fma(ka2, (pg8::f32x2){nH, nH}, k2 * vv));
                sP[k] = p2.x; sP[k + 1] = p2.y; sH[k] = h2.x; sH[k + 1] = h2.y;
                q2 = __builtin_elementwise_fma(p2, r2, q2); l2 = __builtin_elementwise_fma(h2, r2, l2); }
            kkab[base] = q2.x + q2.y;
            wb[base] = l2.x + l2.y;
            kb[base] = pr; }
        float* dP = Pm + (size_t)bhc * 4096 + lane * 64; float* dH = Hm + (size_t)bhc * 4096 + lane * 64;
#pragma unroll
        for (int k4 = 0; k4 < 16; ++k4) { *(f32x4*)(dP + 4 * k4) = (f32x4){sP[4 * k4], sP[4 * k4 + 1], sP[4 * k4 + 2], sP[4 * k4 + 3]}; *(f32x4*)(dH + 4 * k4) = (f32x4){sH[4 * k4], sH[4 * k4 + 1], sH[4 * k4 + 2], sH[4 * k4 + 3]}; }
    }
}
__device__ __forceinline__ void scan2_phase(const float* Pm, const float* Hm, float* Si, LAS float* lds) {
    const int tid = o_tid(), wid = tid >> 6, lane = tid & 63;
    for (int item = o_bid(); item < 256; item += o_grid()) {
        const int it = (item & 7) * 32 + (item >> 3);
        const int bh = it >> 3, rg = it & 7, v = rg * 8 + wid;
        const float* Pb = Pm + (size_t)bh * 64 * 4096 + tid * 8; const float* Hb = Hm + (size_t)bh * 64 * 4096 + v * 64 + lane; float* Sb = Si + (size_t)bh * 64 * 4096 + v * 64 + lane;
        float s = 0.f; f32x4 pre[4][2]; float hq[4];
#pragma unroll
        for (int d = 0; d < 4; ++d) { pre[d][0] = *(const f32x4*)(Pb + (size_t)d * 4096); pre[d][1] = *(const f32x4*)(Pb + (size_t)d * 4096 + 4); hq[d] = Hb[(size_t)d * 4096]; }
#pragma unroll 1
        for (int c0 = 0; c0 < 64; c0 += 4) {
#pragma unroll
            for (int pr = 0; pr < 2; ++pr) { const int c = c0 + 2 * pr;
                LAS float* buf = lds + ((c >> 1) & 1) * 8192;
                *(LAS f32x4*)(buf + tid * 8) = pre[2 * pr][0]; *(LAS f32x4*)(buf + tid * 8 + 4) = pre[2 * pr][1];
                *(LAS f32x4*)(buf + 4096 + tid * 8) = pre[2 * pr + 1][0]; *(LAS f32x4*)(buf + 4096 + tid * 8 + 4) = pre[2 * pr + 1][1];
                const float h0 = hq[2 * pr], h1 = hq[2 * pr + 1];
                __syncthreads();
                if (c + 4 < 64) {
#pragma unroll
                    for (int d = 0; d < 2; ++d) { pre[2 * pr + d][0] = *(const f32x4*)(Pb + (size_t)(c + 4 + d) * 4096); pre[2 * pr + d][1] = *(const f32x4*)(Pb + (size_t)(c + 4 + d) * 4096 + 4); hq[2 * pr + d] = Hb[(size_t)(c + 4 + d) * 4096]; } }
#pragma unroll
                for (int d = 0; d < 2; ++d) { Sb[(size_t)(c + d) * 4096] = s;
                    float acc = d == 0 ? h0 : h1; const int si = __float_as_int(s); const LAS float* bp = buf + d * 4096 + lane;
#pragma unroll
                    for (int i = 0; i < 64; ++i) acc = fmaf(__int_as_float(__builtin_amdgcn_readlane(si, i)), bp[i * 64], acc);
                    s = acc; } }
        }
        __syncthreads();
    }
}
__device__ __forceinline__ void scan3_phase(const float* rb, const float* olb, const float* qb, const float* kb, const bf16_t* vb, const bf16_t* gb, const float* Sinit,
                                            const float* ln_w, const float* ln_b, const float* r_k, bf16_t* mix, LAS float* lds) {
    const int wid = __builtin_amdgcn_readfirstlane(o_tid() >> 6), lane = o_tid() & 63;
    LAS float* ob = lds + wid * 4096;
#pragma unroll 1
    for (int bhc = o_bid() * 8 + wid; bhc < 2048; bhc += o_grid() * 8) {
        const int b = bhc >> 9, h = (bhc >> 6) & 7, c = bhc & 63;
        const size_t base0 = ((size_t)(b * SEQ + c * 64)) * 512 + h * 64;
        float s[64];
        { const float* sp = Sinit + (size_t)bhc * 4096 + lane * 64;
#pragma unroll
          for (int k4 = 0; k4 < 16; ++k4) { const f32x4 t4 = *(const f32x4*)(sp + 4 * k4); s[4 * k4] = t4[0]; s[4 * k4 + 1] = t4[1]; s[4 * k4 + 2] = t4[2]; s[4 * k4 + 3] = t4[3]; } }
        float qn[4], on[4];
#pragma unroll
        for (int d = 0; d < 4; ++d) { qn[d] = qb[base0 + (size_t)d * 512 + lane]; on[d] = olb[base0 + (size_t)d * 512 + lane]; }
#pragma unroll 1
        for (int t0 = 0; t0 < 64; t0 += 4) {
#pragma unroll
            for (int d = 0; d < 4; ++d) { const int t = t0 + d;
                const int qi = __float_as_int(qn[d]); float o0 = on[d], o1 = 0.f;
                if (t + 4 < 64) { qn[d] = qb[base0 + (size_t)(t + 4) * 512 + lane]; on[d] = olb[base0 + (size_t)(t + 4) * 512 + lane]; }
#pragma unroll
                for (int i = 0; i < 64; i += 2) { o0 = fmaf(s[i], __int_as_float(__builtin_amdgcn_readlane(qi, i)), o0); o1 = fmaf(s[i + 1], __int_as_float(__builtin_amdgcn_readlane(qi, i + 1)), o1); }
                ob[t * 64 + (lane ^ t)] = o0 + o1; }
        }
        { const int t = lane; const size_t tb = base0 + (size_t)t * 512; const LAS float* orow = ob + t * 64;
          float mean = 0.f;
#pragma unroll
          for (int v = 0; v < 64; ++v) mean += orow[v ^ t];
          mean *= (1.0f / 64.0f); float var = 0.f;
#pragma unroll
          for (int v = 0; v < 64; ++v) { const float d = orow[v ^ t] - mean; var = fmaf(d, d, var); }
          const float rstd = 1.0f / sqrtf(var * (1.0f / 64.0f) + 64e-5f);
          float bonus = 0.f;
#pragma unroll 4
          for (int k4 = 0; k4 < 16; ++k4) { const f32x4 pr = *(const f32x4*)(kb + tb + 4 * k4); bonus += (pr[0] + pr[1]) + (pr[2] + pr[3]); }
          bf16_t* op = mix + (size_t)(b * SEQ + c * 64 + t) * 1024 + 512 + h * 64;
#pragma unroll
          for (int v8 = 0; v8 < 8; ++v8) { const u32x4 vw = *(const u32x4*)(vb + tb + 8 * v8), gw = *(const u32x4*)(gb + tb + 8 * v8); float o8[8];
#pragma unroll
              for (int e = 0; e < 8; ++e) { const int v = 8 * v8 + e; const unsigned vwe = vw[e >> 1], gwe = gw[e >> 1];
                  const float vvv = (e & 1) ? __uint_as_float(vwe & 0xffff0000u) : bf2f(vwe & 0xffffu), gg = (e & 1) ? __uint_as_float(gwe & 0xffff0000u) : bf2f(gwe & 0xffffu);
                  const float on = (orow[v ^ t] - mean) * rstd * ln_w[h * 64 + v] + ln_b[h * 64 + v]; o8[e] = (on + bonus * vvv) * gg; }
              u32x4 w; w.x = pk(o8[0], o8[1]); w.y = pk(o8[2], o8[3]); w.z = pk(o8[4], o8[5]); w.w = pk(o8[6], o8[7]); *(u32x4*)(op + 8 * v8) = w; }
        }
    }
}

__device__ __forceinline__ void conv_phase(const bf16_t* P2, const float* cw, const float* cb, bf16_t* xcg) {
#pragma unroll 1
    for (int e = o_bid() * 512 + o_tid(); e < (MT / 8) * 160; e += o_grid() * 512) {
        const int run = e / 160, grp = e - run * 160, ch0 = grp * 8, tok0 = run * 8;
        float w[4][8], bb[8], win[3][8];
#pragma unroll
        for (int j = 0; j < 4; ++j) { const f32x4 a0 = *(const f32x4*)(cw + j * 1280 + ch0), a1 = *(const f32x4*)(cw + j * 1280 + ch0 + 4);
#pragma unroll
            for (int i = 0; i < 4; ++i) { w[j][i] = a0[i]; w[j][4 + i] = a1[i]; } }
        { const f32x4 a0 = *(const f32x4*)(cb + ch0), a1 = *(const f32x4*)(cb + ch0 + 4);
#pragma unroll
          for (int i = 0; i < 4; ++i) { bb[i] = a0[i]; bb[4 + i] = a1[i]; } }
        const bool head = (tok0 & (SEQ - 1)) == 0; const bf16_t* src = P2 + (size_t)tok0 * 2560 + 1280 + ch0;
#pragma unroll
        for (int j = 0; j < 3; ++j) { u32x4 v = {0u, 0u, 0u, 0u}; if (!head) v = *(const u32x4*)(src - (size_t)(3 - j) * 2560); unpack8(v, win[j]); }
        const int g2 = ch0 >> 8, col = ch0 & 255;
#pragma unroll
        for (int t = 0; t < 8; ++t) { float cur[8], o[8]; unpack8(*(const u32x4*)(src + (size_t)t * 2560), cur);
#pragma unroll
            for (int i = 0; i < 8; ++i) { o[i] = fmaf(w[3][i], cur[i], fmaf(w[2][i], win[2][i], fmaf(w[1][i], win[1][i], fmaf(w[0][i], win[0][i], bb[i])))); win[0][i] = win[1][i]; win[1][i] = win[2][i]; win[2][i] = cur[i]; }
            *(u32x4*)(xcg + ((size_t)g2 * MT + tok0 + t) * 256 + col) = pack8(o); }
    }
}
__device__ __forceinline__ void cscan1_phase(const float* ab, const float* bb, float* sA, float* sH) {
#pragma unroll 1
    for (int e = o_bid() * 512 + o_tid(); e < 4 * 64 * 320; e += o_grid() * 512) {
        const int bc = e / 320, c4 = (e - bc * 320) * 4, b = bc >> 6, c = bc & 63; const size_t o0 = (size_t)(b * SEQ + c * 64) * 1280 + c4;
        f32x4 A = {1.f, 1.f, 1.f, 1.f}, hh = {0.f, 0.f, 0.f, 0.f};
#pragma unroll 8
        for (int t = 0; t < 64; ++t) { const f32x4 av = *(const f32x4*)(ab + o0 + (size_t)t * 1280), bv = *(const f32x4*)(bb + o0 + (size_t)t * 1280); hh = av * hh + bv; A = A * av; }
        *(f32x4*)(sA + (size_t)bc * 1280 + c4) = A; *(f32x4*)(sH + (size_t)bc * 1280 + c4) = hh;
    }
}
__device__ __forceinline__ void cscan2_phase(const float* ab, const float* bb, const float* sA, const float* sH, const bf16_t* P2, bf16_t* y) {
#pragma unroll 1
    for (int e = o_bid() * 512 + o_tid(); e < 4 * 64 * 320; e += o_grid() * 512) {
        const int bc = e / 320, c4 = (e - bc * 320) * 4, b = bc >> 6, c = bc & 63; const size_t tok0 = (size_t)(b * SEQ + c * 64);
        f32x4 hh = {0.f, 0.f, 0.f, 0.f};
#pragma unroll 4
        for (int j = 0; j < c; ++j) { const size_t idx = (size_t)(b * 64 + j) * 1280 + c4; hh = hh * *(const f32x4*)(sA + idx) + *(const f32x4*)(sH + idx); }
#pragma unroll 8
        for (int t = 0; t < 64; ++t) { const size_t tok = tok0 + t; const f32x4 av = *(const f32x4*)(ab + tok * 1280 + c4), bv = *(const f32x4*)(bb + tok * 1280 + c4); hh = av * hh + bv;
            const u32x2 gw = *(const u32x2*)(P2 + tok * 2560 + c4);
            u32x2 w; w.x = pk(hh[0] * bf2f(gw.x & 0xffffu), hh[1] * __uint_as_float(gw.x & 0xffff0000u)); w.y = pk(hh[2] * bf2f(gw.y & 0xffffu), hh[3] * __uint_as_float(gw.y & 0xffff0000u));
            *(u32x2*)(y + tok * 1280 + c4) = w; }
    }
}

#define XB_TMO      128
#define XB_XCNT(j)  (256  + 64 * (j))
#define XB_XSUB(j)  (1280 + 64 * (j))
#define XB_XGEN(j)  (2304 + 64 * (j))
#define XB_TOP      3328
#define XB_TOPGEN   3392
#define XCD_BAR_WORDS 3456
#define XB_SPIN_CAP (1u << 18)

__device__ __forceinline__ unsigned xb_ld(unsigned* p)              { return __hip_atomic_load(p, __ATOMIC_RELAXED, __HIP_MEMORY_SCOPE_AGENT); }
__device__ __forceinline__ unsigned xb_add(unsigned* p, unsigned v) { return __hip_atomic_fetch_add(p, v, __ATOMIC_RELAXED, __HIP_MEMORY_SCOPE_AGENT); }
__device__ __forceinline__ unsigned xb_xcc_id() { return (unsigned)__builtin_amdgcn_s_getreg((3 << 11) | 20) & 0xFu; }
#define XB_SPIN(cond, bar) do { unsigned _sp = 0; while (cond) { __builtin_amdgcn_s_sleep(1); \
    if ((++_sp & 255u) == 0u) { if (xb_ld(&(bar)[XB_TMO])) break; if (_sp > XB_SPIN_CAP) { atomicAdd(&(bar)[XB_TMO], 1u); break; } } } } while (0)

struct XcdBarrier {
    unsigned* bar; unsigned x;
    volatile LAS unsigned* st;
};

__device__ __forceinline__ XcdBarrier xcd_barrier_post(unsigned* bar, volatile LAS unsigned* st) {
    XcdBarrier b; b.bar = bar; b.x = xb_xcc_id(); b.st = st;
    if (threadIdx.x == 0) (void)xb_add(&bar[XB_XCNT(b.x)], 1u);
    return b;
}
__device__ __forceinline__ void xcd_barrier_complete(unsigned* bar, unsigned x, unsigned& nloc, unsigned& nx) {
    const unsigned G = gridDim.x * gridDim.y * gridDim.z;
    unsigned sum, cnt, mine, sp = 0u;
    for (;;) {
        sum = 0u; cnt = 0u; mine = 0u;
#pragma unroll
        for (unsigned j = 0; j < 16; ++j) { const unsigned c = xb_ld(&bar[XB_XCNT(j)]); sum += c; cnt += (c > 0u) ? 1u : 0u; mine = (j == x) ? c : mine; }
        if (sum == G) break;
        __builtin_amdgcn_s_sleep(1);
        if ((++sp & 255u) == 0u) { if (xb_ld(&bar[XB_TMO])) break; if (sp > XB_SPIN_CAP) { atomicAdd(&bar[XB_TMO], 1u); break; } }
    }
    nloc = mine > 0u ? mine : 1u; nx = cnt > 0u ? cnt : 1u;
}

__device__ __forceinline__ void xcd_barrier(const XcdBarrier& b) {
    asm volatile("s_waitcnt vmcnt(0)" ::: "memory");
    __syncthreads();
    if (threadIdx.x == 0) {
        unsigned* bar = b.bar;
        __builtin_amdgcn_s_waitcnt(0);
        unsigned nloc = b.st[0], nx = b.st[1];
        if (nloc == 0u) { xcd_barrier_complete(bar, b.x, nloc, nx); b.st[0] = nloc; b.st[1] = nx; }
        const unsigned old = xb_add(&bar[XB_XSUB(b.x)], 1u);
        const unsigned gen = old / nloc;
        if (old + 1u == (gen + 1u) * nloc) {
            __builtin_amdgcn_fence(__ATOMIC_RELEASE, "agent");
            asm volatile("s_waitcnt vmcnt(0)" ::: "memory");
            const unsigned og = xb_add(&bar[XB_TOP], 1u);
            const unsigned tg = og / nx;
            if (og + 1u == (tg + 1u) * nx) xb_add(&bar[XB_TOPGEN], 1u);
            else XB_SPIN(xb_ld(&bar[XB_TOPGEN]) == tg, bar);
            __builtin_amdgcn_fence(__ATOMIC_ACQUIRE, "agent");
            xb_add(&bar[XB_XGEN(b.x)], 1u);
            asm volatile("s_waitcnt vmcnt(0)" ::: "memory");
        } else {
            XB_SPIN(xb_ld(&bar[XB_XGEN(b.x)]) == gen, bar);
            __builtin_amdgcn_fence(__ATOMIC_ACQUIRE, "agent");
            asm volatile("s_waitcnt vmcnt(0)" ::: "memory");
        }
    }
    __syncthreads();
}


constexpr int PH_PER_LAYER = 14, PH_TOTAL = 4 * PH_PER_LAYER + 1;
__host__ __device__ inline bool phase_skipped(int idx) { const int l = idx / PH_PER_LAYER, s = idx - l * PH_PER_LAYER; if (idx >= 4 * PH_PER_LAYER) return false;
    return ((l & 1) && s == 9) || (s == 0 && l > 0) || s == 3 || s == 11; }
__global__ __launch_bounds__(512, 2) void mega(Params p, int first, int last) {
    extern __shared__ __attribute__((aligned(16))) unsigned char shm[];
    LAS unsigned char* lds = (LAS unsigned char*)shm;
#if MODE_COOP
    volatile LAS unsigned* xst = (volatile LAS unsigned*)(lds + 131072);
    if (threadIdx.x == 0) { xst[0] = 0u; xst[1] = 0u; xst[2] = 0u; xst[3] = 0u; }
    __syncthreads();
    const XcdBarrier xb = xcd_barrier_post((unsigned*)(p.ws + OFF_BAR), xst);
#endif
    for (int idx = first; idx < last; ++idx) {
        GAS unsigned char* wsg; GAS float* xog; asm volatile("" : "=s"(wsg), "=s"(xog) : "0"(p.ws), "1"(p.out));
        unsigned char* ws = (unsigned char*)wsg; float* xo = (float*)xog;
        bf16_t* xbf = (bf16_t*)(ws + OFF_XB); unsigned* ssb = (unsigned*)(ws + OFF_SS);
        const int l = idx / PH_PER_LAYER, s = idx - l * PH_PER_LAYER, odd = l & 1, i2 = l >> 1;
        if (phase_skipped(idx)) continue;
#if MODE_COOP
        if (idx > first) { if (last == -12345) cg::this_grid().sync(); xcd_barrier(xb); }
#endif
        if (idx == 4 * PH_PER_LAYER) { norm_phase<true>(xo, pin(p, I_NFIN), nullptr, xo); continue; }
        unsigned char* ar = ws + OFF_AR; const EvenMap em = even_map(i2);
        bf16_t* w9gu = (bf16_t*)(ws + OFF_W9); bf16_t* w9dn = (bf16_t*)(ws + OFF_W9 + SZ_WGU); bf16_t* wagu = (bf16_t*)(ws + OFF_WA); bf16_t* wadn = (bf16_t*)(ws + OFF_WA + SZ_WGU);
        bf16_t* mix = (bf16_t*)(ws + OFF_W9);
        if (s == 0) { prologue_phase(pin(p, I_X), xbf, ssb); convert_ffn(p, 0, 0, w9gu, w9dn, (LAS float*)lds); convert_mixer(p, 0, (LAS float*)lds); continue; }
        if (s == 4) convert_ffn(p, l, 1, wagu, wadn, (LAS float*)lds);
        if (s == 12 && l < 3) { convert_ffn(p, l + 1, 0, w9gu, w9dn, (LAS float*)lds); convert_mixer(p, l + 1, (LAS float*)lds); }
        int ek = -1; const bf16_t* gA = nullptr; const bf16_t* gB = nullptr; int gN = 0, gK = 0;
        const float* r_src = nullptr; float r_scale = 0.f; unsigned* r_ss = nullptr; bf16_t* b_O = nullptr; int b_ldc = 0, b_gelu = 0; const unsigned* ssin = nullptr;
        if (s == 1 || s == 12) { ek = 0; gA = xbf; gB = s == 1 ? w9gu : wagu; gN = 5632; gK = 1024; ssin = ssb + (size_t)(l * 3 + (s == 12 ? 2 : 0)) * MT; }
        else if (s == 2 || s == 13) { ek = 1; gA = (const bf16_t*)(ws + OFF_FF); gB = s == 2 ? w9dn : wadn; gN = 1024; gK = 2816;
            r_src = (l == 0 && s == 2) ? pin(p, I_X) : xo; r_scale = 0.5f; r_ss = ssb + (size_t)(s == 2 ? l * 3 + 1 : (l + 1) * 3) * MT; }
        else if (s == 10) { ek = 1; gN = 1024; r_src = xo; r_scale = 1.0f; r_ss = ssb + (size_t)(l * 3 + 2) * MT;
            if (!odd) { gA = mix; gB = (const bf16_t*)(ws + OFF_WOUT); gK = 1024; } else { gA = (const bf16_t*)(ws + OFF_XCG); gB = (const bf16_t*)(ws + OFF_COUT); gK = 1280; } }
        else if (s == 4) { ek = 2; gA = xbf; gK = 1024; ssin = ssb + (size_t)(l * 3 + 1) * MT;
            if (!odd) { gB = (const bf16_t*)(ws + OFF_WIN); gN = 3328; b_O = (bf16_t*)(ar + em.P); b_ldc = 3328; b_gelu = 0; }
            else { gB = (const bf16_t*)(ws + OFF_CIN); gN = 2560; b_O = (bf16_t*)(ws + OFF_P2); b_ldc = 2560; b_gelu = 5; } }
        if (ek >= 0) {
            const pg8::Gemm g{gA, gB, MT, gN, gK};
            pg8::StaticOrder S; S.init(MT, gN, o_grid(), o_bid());
            LAS float* rtab = (LAS float*)(lds + 131072 + 256);
            if (ek != 1) { Unit u0; fill_row_scales(rtab, ssin, S.next(0, u0) ? u0.pm : 0); }
            if (ek == 0) { const EpiSwiglu E{(bf16_t*)(ws + OFF_FF), ssin, rtab}; pg8::gemm_phase<EpiSwiglu, pg8::StaticOrder, false>(lds, g, S, E, nullptr); }
            else if (ek == 1) { LAS ResidDesc* rd = (LAS ResidDesc*)(lds + 131072 + 64);
                if (threadIdx.x == 0) { rd->src = r_src; rd->dst = xo; rd->xb = xbf; rd->ss = r_ss; rd->scale = r_scale; rd->pad = 0; }
                __syncthreads();
                const EpiResid E{rd}; pg8::gemm_phase<EpiResid, pg8::StaticOrder, false>(lds, g, S, E, nullptr); }
            else { const EpiBf16Act E{b_O, b_ldc, b_gelu, ssin, rtab}; pg8::gemm_phase<EpiBf16Act, pg8::StaticOrder, false>(lds, g, S, E, nullptr); }
            continue;
        }
        if (!odd) {
            float* rbuf = (float*)(ar + em.r); float* kbuf = (float*)(ar + em.k); float* kkbuf = (float*)(ar + em.kk); float* wbuf = (float*)(ar + em.w); float* kkabuf = (float*)(ar + em.kka);
            bf16_t* gbuf = (bf16_t*)(ar + em.g); bf16_t* vfirst = (bf16_t*)(ws + OFF_VF); bf16_t* vsh = (bf16_t*)(ar + em.vsh); bf16_t* v2 = (bf16_t*)(ar + em.v2); bf16_t* alora = (bf16_t*)(ar + em.al);
            const bf16_t* vscan = i2 == 0 ? vfirst : v2; const bf16_t* Pb = (const bf16_t*)(ar + em.P);
            float* Pm = (float*)(ar + em.pm); float* Hm = (float*)(ar + em.hm); float* Sim = (float*)(ar + em.si);
            if (s == 5) {
                prep_phase(Pb, pin(p, I_MU) + (size_t)i2 * 1792, pin(p, I_KK) + (size_t)i2 * 512, rbuf, kbuf, kkbuf, i2 == 0 ? vfirst : vsh, alora);
                attn_phase(Pb, pin(p, I_RELB) + (size_t)i2 * 8 * 257, mix, lds);
            } else if (s == 6) {
                { pg8::Gemm gl{alora, (const bf16_t*)(ws + OFF_WLORA), MT, 1536, 256}; pg8::StaticOrder S; S.init(MT, 1536, o_grid(), o_bid());
                  EpiLora E{wbuf, kkabuf, gbuf, pin(p, I_W0) + (size_t)i2 * 512, pin(p, I_A0) + (size_t)i2 * 512};
                  pg8::gemm_phase<EpiLora, pg8::StaticOrder, false>(lds, gl, S, E, nullptr); }
                if (i2 == 1) { pg8::Gemm gv{vsh, (const bf16_t*)(ws + OFF_WV), MT, 512, 512}; pg8::StaticOrder S; S.init(MT, 512, o_grid(), o_bid());
                  EpiVLora E{vsh, vfirst, v2, pin(p, I_V0)};
                  pg8::gemm_phase<EpiVLora, pg8::StaticOrder, false>(lds, gv, S, E, nullptr); }
            } else if (s == 7) scan1_phase(wbuf, kkbuf, kkabuf, kbuf, rbuf, vscan, pin(p, I_KA) + (size_t)i2 * 512, pin(p, I_RK) + (size_t)i2 * 512, Pm, Hm);
            else if (s == 8) scan2_phase(Pm, Hm, Sim, (LAS float*)lds);
            else if (s == 9) scan3_phase(rbuf, wbuf, kkabuf, kbuf, vscan, gbuf, Sim, pin(p, I_LNW) + (size_t)i2 * 512, pin(p, I_LNB) + (size_t)i2 * 512, pin(p, I_RK) + (size_t)i2 * 512, mix, (LAS float*)lds);
        } else {
            const bf16_t* P2 = (const bf16_t*)(ws + OFF_P2); float* xc = (float*)(ws + OFF_XC); bf16_t* xcg = (bf16_t*)(ws + OFF_XCG); float* ab = (float*)(ws + OFF_A);
            float* sA = (float*)(ws + OFF_SA); float* sH = (float*)(ws + OFF_SH);
            if (s == 5) conv_phase(P2, pin(p, I_CCW) + (size_t)i2 * 4 * 1280, pin(p, I_CCB) + (size_t)i2 * 1280, xcg);
            else if (s == 6) { pg8::Gemm gg{xcg, (const bf16_t*)(ws + OFF_WGATES), 5 * MT, 2560, 256}; GatesOrder S{o_grid(), o_bid()};
                EpiGates E{xcg, xc, ab, pin(p, I_CBA) + (size_t)i2 * 1280, pin(p, I_CBX) + (size_t)i2 * 1280, pin(p, I_LAM) + (size_t)i2 * 1280};
                pg8::gemm_phase<EpiGates, GatesOrder, false>(lds, gg, S, E, nullptr); }
            else if (s == 7) cscan1_phase(ab, xc, sA, sH);
            else if (s == 8) cscan2_phase(ab, xc, sA, sH, P2, xcg);
        }
    }
}

extern "C" void kernel_launch(void* const* d_in, const int* in_sizes, int n_in, void* d_out, int out_size, void* d_ws, size_t ws_size, hipStream_t stream) {
    static int grid = 0;
    if (grid == 0) {
        if (n_in != 33 || out_size != MT * DM || ws_size < WS_NEED) { fprintf(stderr, "kernel_launch: unexpected shapes (n_in %d, out %d, ws %zu, need %zu)\n", n_in, out_size, ws_size, (size_t)WS_NEED); grid = -1; return; }
        int dev = 0, cus = 0, per_cu = 0;
        hipGetDevice(&dev); hipDeviceGetAttribute(&cus, hipDeviceAttributeMultiprocessorCount, dev);
        if (hipFuncSetAttribute((const void*)mega, hipFuncAttributeMaxDynamicSharedMemorySize, LDS_BYTES) != hipSuccess) { fprintf(stderr, "kernel_launch: hipFuncSetAttribute failed\n"); grid = -1; return; }
        if (hipOccupancyMaxActiveBlocksPerMultiprocessor(&per_cu, (const void*)mega, 512, LDS_BYTES) != hipSuccess || per_cu < 1) { fprintf(stderr, "kernel_launch: occupancy query says %d\n", per_cu); per_cu = 1; }
        (void)hipGetLastError();
        grid = cus * (per_cu > 1 ? 1 : per_cu); if (grid > 256) grid = 256;
    }
    if (grid < 0) return;
    Params p{}; for (int i = 0; i < 33; ++i) p.in[i] = (const float*)d_in[i];
    p.out = (float*)d_out; p.ws = (unsigned char*)d_ws;
#if MODE_COOP
    if (hipMemsetAsync((unsigned char*)d_ws + OFF_BAR, 0, 16384, stream) != hipSuccess) { fprintf(stderr, "kernel_launch: memset of barrier words failed\n"); return; }
    int first = 0, last = PH_TOTAL; void* args[] = {&p, &first, &last};
    hipError_t e = hipLaunchCooperativeKernel((const void*)mega, dim3(grid), dim3(512), args, LDS_BYTES, stream);
    if (e != hipSuccess) fprintf(stderr, "cooperative launch failed: %s (grid %d)\n", hipGetErrorString(e), grid);
#else
    for (int idx = 0; idx < PH_TOTAL; ++idx) {
        if (phase_skipped(idx)) continue;
        hipLaunchKernelGGL(mega, dim3(grid), dim3(512), LDS_BYTES, stream, p, idx, idx + 1);
    }
#endif
}
```

```cpp
#include <hip/hip_runtime.h>
#include <hip/hip_cooperative_groups.h>
#include <cstdio>
namespace cg = cooperative_groups;
#ifndef MODE_COOP
#define MODE_COOP 1
#endif
__device__ __forceinline__ int o_tid() { int t = threadIdx.x; asm volatile("" : "+v"(t)); return t; }
__device__ __forceinline__ int o_bid() { int t = blockIdx.x; asm volatile("" : "+s"(t)); return t; }
__device__ __forceinline__ int o_grid() { int t = gridDim.x; asm volatile("" : "+s"(t)); return t; }
namespace pg8 {
#define PG8_LAS __attribute__((address_space(3)))
typedef unsigned short bf16_t;
typedef short bf16x8 __attribute__((ext_vector_type(8)));
typedef float f32x4 __attribute__((ext_vector_type(4)));
typedef unsigned u32x4 __attribute__((ext_vector_type(4)));
constexpr int BM = 256, BK = 64, HALF = 128, HTB = HALF * BK * 2  , STAGE_BYTES = 8 * HTB, NXCD = 8, WGM = 8;

__host__ __device__ __forceinline__ int lds_byte(int r, int c) { const int st = (r >> 4) * 2 + (c >> 5), rr = r & 15, cc = c & 31, ob = rr * 64 + cc * 2; return st * 1024 + (ob ^ (((ob >> 9) & 1) << 5)); }
__host__ __device__ __forceinline__ void stage_rc(int b, int& R, int& C) { const int st = b / 1024, sb = b % 1024, swz = sb ^ (((sb >> 9) & 1) << 5); R = (st >> 1) * 16 + swz / 64; C = (st & 1) * 32 + (swz % 64) / 2; }
__host__ __device__ __forceinline__ int perm32(int rho) { const int n = rho >> 4, i = rho & 15; return 8 * (i >> 2) + 4 * n + (i & 3); }

struct Unit { int pm, pn; };
struct Gemm { const bf16_t* A; const bf16_t* Bt; int M, N, K; };

struct StaticOrder {
    int nM, nN, nwg, G, c;
    __host__ __device__ void init(int M, int N, int G_, int c_) { nM = M / BM; nN = N / BM; nwg = nM * nN; G = G_; c = c_; }
    __host__ __device__ bool next(int i, Unit& u) const {
        const long L = (long)i * G + c; if (L >= nwg) return false;
        int wgid = (int)L; { const int q = nwg / NXCD, r = nwg % NXCD, xcd = wgid % NXCD, off = wgid / NXCD; wgid = (xcd < r ? xcd * (q + 1) : r * (q + 1) + (xcd - r) * q) + off; }
        const int nig = WGM * nN, gid = wgid / nig, fm = gid * WGM, gsz = (nM - fm) < WGM ? (nM - fm) : WGM;
        u.pm = fm + ((wgid % nig) % gsz); u.pn = (wgid % nig) / gsz; return true;
    }
    __device__ __forceinline__ void a_ready(const Unit&) const {}
    __device__ __forceinline__ void done(const Unit&) const {}
};
__device__ __forceinline__ unsigned cvt_pk_bf16(float lo, float hi) { unsigned r; asm volatile("v_cvt_pk_bf16_f32 %0, %1, %2" : "=v"(r) : "v"(lo), "v"(hi)); return r; }
typedef float f32x2 __attribute__((ext_vector_type(2)));
template <class Epi, class Sched, bool STAMP = false>
__device__ __forceinline__ void gemm_phase(PG8_LAS unsigned char* lds, const Gemm g, const Sched& S, const Epi& E, unsigned long long* stamps) {
    const int tid = o_tid(), wid = __builtin_amdgcn_readfirstlane(tid >> 6), lane = tid & 63, wr = wid >> 2, wc = wid & 3, fr = lane & 15, fq = lane >> 4;
    int Kq_ = g.K; asm volatile("" : "+s"(Kq_)); const int K = Kq_, nt = K / BK;
    int ts_lo = 0, ts_hi = 0, nts = 0; const unsigned long long rt_entry = STAMP ? (unsigned long long)wall_clock64() : 0ull;
#define PG8_STAMP() do { if (STAMP && wid == 0 && nts < 64) { const unsigned long long _c = (unsigned long long)clock64(); \
        ts_lo = (lane == nts) ? (int)(unsigned)_c : ts_lo; ts_hi = (lane == nts) ? (int)(unsigned)(_c >> 32) : ts_hi; ++nts; } } while (0)
    PG8_STAMP();
    unsigned voffA[2], voffB[2];
#pragma unroll
    for (int i = 0; i < 2; ++i) { int R, C; stage_rc(tid * 16 + i * 8192, R, C); const int Rb = Epi::PERM ? ((R & ~31) + perm32(R & 31)) : R;
        voffA[i] = (unsigned)(R * K + C) * 2u; voffB[i] = (unsigned)(Rb * K + C) * 2u; }
    const size_t kstep = (size_t)(BK * 2);
    const size_t hstep = (size_t)HALF * K * 2;
    const size_t tstep = 2 * hstep;
    const unsigned ldsw = (unsigned)wid * 1024u;
    const int aoff = lds_byte(wr * 64 + fr, fq * 8), boff = lds_byte(wc * 32 + fr, fq * 8);
#define PG8_SA(b, h) (((b) * 2 + (h)) * HTB)
#define PG8_SB(b, h) ((4 + (b) * 2 + (h)) * HTB)
#define PG8_STAGE(bufoff, gbase, voff) do { _Pragma("unroll") for (int _i = 0; _i < 2; ++_i) \
        __builtin_amdgcn_global_load_lds((const unsigned*)((const char*)(gbase) + (voff)[_i]), (PG8_LAS unsigned*)(lds + (bufoff) + ldsw + _i * 8192), 16, 0, 0); } while (0)
#define PG8_LDA(dst, b, h) do { _Pragma("unroll") for (int m = 0; m < 4; ++m) _Pragma("unroll") for (int k = 0; k < 2; ++k) dst[m][k] = *(const PG8_LAS bf16x8*)(lds + PG8_SA(b, h) + aoff + m * 2048 + k * 1024); } while (0)
#define PG8_LDB(dst, b, h) do { _Pragma("unroll") for (int n = 0; n < 2; ++n) _Pragma("unroll") for (int k = 0; k < 2; ++k) dst[n][k] = *(const PG8_LAS bf16x8*)(lds + PG8_SB(b, h) + boff + n * 2048 + k * 1024); } while (0)
#define PG8_MMA(ai, bj, At, Bt) do { __builtin_amdgcn_s_setprio(1); _Pragma("unroll") for (int m = 0; m < 4; ++m) _Pragma("unroll") for (int n = 0; n < 2; ++n) _Pragma("unroll") for (int k = 0; k < 2; ++k) \
        acc[ai][bj][m][n] = __builtin_amdgcn_mfma_f32_16x16x32_bf16(Bt[n][k], At[m][k], acc[ai][bj][m][n], 0, 0, 0); __builtin_amdgcn_s_setprio(0); } while (0)
#define PG8_WAIT_V(n) asm volatile("s_waitcnt vmcnt(" #n ")" ::: "memory")
#define PG8_WAIT_L(n) asm volatile("s_waitcnt lgkmcnt(" #n ")" ::: "memory")
#define PG8_BAR __builtin_amdgcn_s_barrier()
#define PG8_SCHED __builtin_amdgcn_sched_barrier(0)
    Unit cur, nxt; int ui = 0;
    if (!S.next(0, cur)) return;
    f32x4 acc[2][2][4][2];
#pragma unroll
    for (int a = 0; a < 2; ++a)
#pragma unroll
        for (int b = 0; b < 2; ++b)
#pragma unroll
            for (int m = 0; m < 4; ++m)
#pragma unroll
                for (int n = 0; n < 2; ++n) acc[a][b][m][n] = (f32x4){0.f, 0.f, 0.f, 0.f};
    bf16x8 At[4][2], B0[2][2], B1[2][2];
    const char* cA = (const char*)g.A + (size_t)cur.pm * tstep; const char* cB = (const char*)g.Bt + (size_t)cur.pn * tstep;
    S.a_ready(cur);
    PG8_STAGE(PG8_SB(0, 0), cB, voffB); PG8_STAGE(PG8_SA(0, 0), cA, voffA); PG8_STAGE(PG8_SB(0, 1), cB + hstep, voffB); PG8_STAGE(PG8_SA(0, 1), cA + hstep, voffA);
    if (wr == 1) PG8_BAR;
    PG8_WAIT_V(4); PG8_BAR;
    PG8_STAGE(PG8_SB(1, 0), cB + kstep, voffB); PG8_STAGE(PG8_SA(1, 0), cA + kstep, voffA); PG8_STAGE(PG8_SB(1, 1), cB + hstep + kstep, voffB);
    PG8_WAIT_V(6); PG8_BAR;
    PG8_STAMP();
    for (;;) {
        const bool has_next = S.next(ui + 1, nxt);
        const char* nA = has_next ? (const char*)g.A + (size_t)nxt.pm * tstep : cA; const char* nB = has_next ? (const char*)g.Bt + (size_t)nxt.pn * tstep : cB;
        for (int t = 0; t < nt; t += 2) {
            const bool last = (t == nt - 2);
            const char* a1 = cA + (size_t)(t + 1) * kstep;
            const char* a2 = last ? nA : cA + (size_t)(t + 2) * kstep; const char* b2 = last ? nB : cB + (size_t)(t + 2) * kstep;
            const char* a3 = a2 + kstep; const char* b3 = b2 + kstep;
            if (last && has_next) S.a_ready(nxt);
            PG8_LDB(B0, 0, 0); PG8_SCHED; PG8_LDA(At, 0, 0); PG8_STAGE(PG8_SA(1, 1), a1 + hstep, voffA);
            PG8_WAIT_L(8); PG8_BAR; PG8_WAIT_L(0); PG8_MMA(0, 0, At, B0); PG8_BAR; PG8_SCHED;
            PG8_LDB(B1, 0, 1); PG8_STAGE(PG8_SB(0, 0), b2, voffB);
            PG8_BAR; PG8_WAIT_L(0); PG8_MMA(0, 1, At, B1); PG8_BAR;
            PG8_LDA(At, 0, 1); PG8_STAGE(PG8_SA(0, 0), a2, voffA);
            PG8_BAR; PG8_WAIT_L(0); PG8_MMA(1, 0, At, B0); PG8_BAR; PG8_SCHED;
            PG8_STAGE(PG8_SB(0, 1), b2 + hstep, voffB);
            PG8_WAIT_V(6); PG8_BAR; PG8_MMA(1, 1, At, B1); PG8_BAR;
            PG8_LDB(B0, 1, 0); PG8_SCHED; PG8_LDA(At, 1, 0); PG8_STAGE(PG8_SA(0, 1), a2 + hstep, voffA);
            PG8_WAIT_L(8); PG8_BAR; PG8_WAIT_L(0); PG8_MMA(0, 0, At, B0); PG8_BAR; PG8_SCHED;
            PG8_LDB(B1, 1, 1); PG8_STAGE(PG8_SB(1, 0), b3, voffB);
            PG8_BAR; PG8_WAIT_L(0); PG8_MMA(0, 1, At, B1); PG8_BAR;
            PG8_LDA(At, 1, 1); PG8_STAGE(PG8_SA(1, 0), a3, voffA);
            PG8_BAR; PG8_WAIT_L(0); PG8_MMA(1, 0, At, B0); PG8_BAR; PG8_SCHED;
            PG8_STAGE(PG8_SB(1, 1), b3 + hstep, voffB);
            PG8_WAIT_V(6); PG8_BAR; PG8_MMA(1, 1, At, B1); PG8_BAR;
        }
        PG8_STAMP();
        if constexpr (!Epi::AFTER_DRAIN) { E(acc, cur, wr, wc, fr, fq); S.done(cur); }
        PG8_STAMP();
        if (!has_next) break;
#pragma unroll
        for (int a = 0; a < 2; ++a)
#pragma unroll
            for (int b = 0; b < 2; ++b)
#pragma unroll
                for (int m = 0; m < 4; ++m)
#pragma unroll
                    for (int n = 0; n < 2; ++n) acc[a][b][m][n] = (f32x4){0.f, 0.f, 0.f, 0.f};
        cur = nxt; cA = nA; cB = nB; ++ui;
    }
    PG8_WAIT_V(0);
    if (wr == 0) PG8_BAR;
    PG8_BAR;
    if constexpr (Epi::AFTER_DRAIN) { E.fused(acc, cur, wr, wc, fr, fq, lds, wid, lane); S.done(cur); }
    PG8_STAMP();
    if (STAMP && wid == 0) { stamps[lane] = lane < nts ? (((unsigned long long)(unsigned)ts_hi << 32) | (unsigned)ts_lo) : 0ull;
        if (lane == 62) stamps[62] = rt_entry; if (lane == 63) stamps[63] = (unsigned long long)wall_clock64(); }
#undef PG8_STAMP
#undef PG8_SA
#undef PG8_SB
#undef PG8_STAGE
#undef PG8_LDA
#undef PG8_LDB
#undef PG8_MMA
#undef PG8_WAIT_V
#undef PG8_WAIT_L
#undef PG8_BAR
#undef PG8_SCHED
}
}

using pg8::bf16_t; using pg8::bf16x8; using pg8::f32x4; using pg8::u32x4; using pg8::Unit; using pg8::BM; using pg8::HALF;
typedef unsigned u32x2 __attribute__((ext_vector_type(2)));
#define LAS __attribute__((address_space(3)))
#define GAS __attribute__((address_space(1)))

constexpr int MT = 16384, SEQ = 4096, DM = 1024, DFF = 2816;
constexpr int LDS_BYTES = 131072 + 2048;

constexpr size_t SZ_WGU = 5632ull * 1024 * 2, SZ_WD = 1024ull * 2816 * 2;
constexpr size_t OFF_WA = 0, END_WA = OFF_WA + SZ_WGU + SZ_WD;
constexpr size_t OFF_WB = END_WA;
constexpr size_t OFF_WIN = OFF_WB, OFF_WOUT = OFF_WIN + 3328ull * 1024 * 2, OFF_WLORA = OFF_WOUT + 1024ull * 1024 * 2, OFF_WV = OFF_WLORA + 1536ull * 256 * 2, END_WEVEN = OFF_WV + 512ull * 512 * 2;
constexpr size_t OFF_CIN = OFF_WB, OFF_COUT = OFF_CIN + 2560ull * 1024 * 2, OFF_WGATES = OFF_COUT + 1024ull * 1280 * 2, END_WODD = OFF_WGATES + 2560ull * 256 * 2;
constexpr size_t OFF_XB = END_WEVEN > END_WODD ? END_WEVEN : END_WODD;
constexpr size_t OFF_VF = OFF_XB + (size_t)MT * 1024 * 2;
constexpr size_t OFF_SS = OFF_VF + (size_t)MT * 512 * 2;
constexpr size_t OFF_AR = OFF_SS + 13ull * MT * 4;
constexpr size_t SLOT = (size_t)MT * 512 * 4, SZ_B512 = (size_t)MT * 512 * 2;
constexpr size_t OFF_FF = OFF_AR;
constexpr size_t OFF_W9 = OFF_AR + 9 * SLOT;
struct EvenMap { size_t w, kka, r, k, kk, P, vsh, al, g, v2, pm, hm, si; };
__device__ __forceinline__ EvenMap even_map(int) {
    EvenMap m; m.w = 0; m.kka = SLOT; m.r = 2 * SLOT; m.k = 3 * SLOT; m.kk = 4 * SLOT; m.P = 5 * SLOT; m.vsh = 8 * SLOT + SLOT / 4; m.al = 8 * SLOT + 3 * SLOT / 4; m.g = 5 * SLOT; m.v2 = 5 * SLOT + SLOT / 2;
    m.pm = 6 * SLOT; m.hm = 7 * SLOT; m.si = 4 * SLOT;
    return m; }
static_assert((size_t)MT * 3328 * 2 <= 3 * SLOT + SLOT / 4, "P fits 3.25 slots");
constexpr size_t OFF_P2 = OFF_AR;
constexpr size_t OFF_XC = OFF_P2 + (size_t)MT * 2560 * 2;
constexpr size_t OFF_XCG = OFF_XC + (size_t)MT * 1280 * 4;
constexpr size_t OFF_A = OFF_XCG + (size_t)MT * 1280 * 2;
constexpr size_t OFF_SA = OFF_A + (size_t)MT * 1280 * 4, OFF_SH = OFF_SA + 4ull * 64 * 1280 * 4, END_ODD = OFF_SH + 4ull * 64 * 1280 * 4;
constexpr size_t OFF_BAR = OFF_AR + 10 * SLOT;
constexpr size_t WS_NEED = OFF_BAR + 16384;
static_assert(END_ODD <= OFF_W9, "odd map");
static_assert(WS_NEED <= 415039552ull, "workspace map larger than the guaranteed minimum (sum of the inputs)");

struct Params { const float* in[33]; float* out; unsigned char* ws; };
enum { I_X = 0, I_NFFN, I_WG, I_WU, I_WDN, I_NMIX, I_ABIN, I_ABOUT, I_RELB, I_MU, I_W0, I_WUP, I_A0, I_AUP, I_GUP, I_KK, I_KA, I_RK, I_LNW, I_LNB, I_V0, I_VDN, I_VUP,
       I_CIN, I_CCW, I_CCB, I_CWA, I_CBA, I_CWX, I_CBX, I_LAM, I_COUT, I_NFIN };

__device__ __forceinline__ const float* pin(const Params& p, int i) { asm volatile("" : "+s"(i)); const float* r = p.in[i]; const GAS float* q; asm volatile("" : "=s"(q) : "0"(r)); return (const float*)q; }
__device__ __forceinline__ float bf2f(unsigned u16) { return __uint_as_float(u16 << 16); }
__device__ __forceinline__ unsigned pk(float a, float b) { return pg8::cvt_pk_bf16(a, b); }
__device__ __forceinline__ bf16_t f2bf(float a) { return (bf16_t)(pg8::cvt_pk_bf16(a, 0.f) & 0xffffu); }
__device__ __forceinline__ float sigm(float x) { return __builtin_amdgcn_rcpf(1.0f + __expf(-x)); }
__device__ __forceinline__ float wsum(float v) {
#pragma unroll
    for (int o = 32; o >= 1; o >>= 1) v += __shfl_xor(v, o);
    return v; }

__device__ __forceinline__ void unpack8(const u32x4 w, float (&f)[8]) {
#pragma unroll
    for (int e = 0; e < 4; ++e) { f[2 * e] = bf2f(w[e] & 0xffffu); f[2 * e + 1] = __uint_as_float(w[e] & 0xffff0000u); } }
__device__ __forceinline__ u32x4 pack8(const float (&f)[8]) { u32x4 w; w.x = pk(f[0], f[1]); w.y = pk(f[2], f[3]); w.z = pk(f[4], f[5]); w.w = pk(f[6], f[7]); return w; }
__device__ __forceinline__ float rs_of(unsigned s) { return 1.0f / sqrtf((float)s * (1.0f / (1024.0f * 1024.0f)) + 1e-6f); }
__device__ __forceinline__ void row_scales(float (&rs)[2][4], const unsigned* ss, const LAS float* rtab, int pm, int row0, int rloc) {
    if (((const LAS int*)rtab)[256] == pm) {
#pragma unroll
        for (int ai = 0; ai < 2; ++ai)
#pragma unroll
            for (int m = 0; m < 4; ++m) rs[ai][m] = rtab[rloc + ai * HALF + m * 16];
    } else { unsigned sv[2][4];
#pragma unroll
        for (int ai = 0; ai < 2; ++ai)
#pragma unroll
            for (int m = 0; m < 4; ++m) sv[ai][m] = ss[row0 + ai * HALF + m * 16];
#pragma unroll
        for (int ai = 0; ai < 2; ++ai)
#pragma unroll
            for (int m = 0; m < 4; ++m) rs[ai][m] = rs_of(sv[ai][m]); }
}
__device__ __forceinline__ void fill_row_scales(LAS float* rtab, const unsigned* ss, int pm) {
    if (threadIdx.x < 256) rtab[threadIdx.x] = rs_of(ss[pm * BM + threadIdx.x]);
    if (threadIdx.x == 0) ((LAS int*)rtab)[256] = pm;
    __syncthreads();
}
struct EpiSwiglu {
    static constexpr bool PERM = true, AFTER_DRAIN = false;
    bf16_t* O; const unsigned* ss; const LAS float* rtab;
    __device__ __forceinline__ void operator()(const f32x4 (&acc)[2][2][4][2], const Unit& u, int wr, int wc, int fr, int fq) const {
        const int row0 = u.pm * BM + wr * 64 + fr, col0 = u.pn * 128 + wc * 32 + 8 * fq;
        float rs[2][4]; row_scales(rs, ss, rtab, u.pm, row0, wr * 64 + fr);
#pragma unroll
        for (int ai = 0; ai < 2; ++ai)
#pragma unroll
            for (int m = 0; m < 4; ++m) {
                bf16_t* rowp = O + (size_t)(row0 + ai * HALF + m * 16) * DFF + col0;
                float hv[8];
#pragma unroll
                for (int n = 0; n < 2; ++n)
#pragma unroll
                    for (int j = 0; j < 4; ++j) { const float g = acc[ai][0][m][n][j] * rs[ai][m], uu = acc[ai][1][m][n][j] * rs[ai][m]; hv[n * 4 + j] = g * sigm(g) * uu; }
                u32x4 w; w.x = pk(hv[0], hv[1]); w.y = pk(hv[2], hv[3]); w.z = pk(hv[4], hv[5]); w.w = pk(hv[6], hv[7]);
                *(u32x4*)rowp = w;
            }
    }
};
struct ResidDesc { const float* src; float* dst; bf16_t* xb; unsigned* ss; float scale; int pad; };
struct EpiResid {
    static constexpr bool PERM = true, AFTER_DRAIN = false;
    const LAS ResidDesc* d;
    __device__ __forceinline__ void operator()(const f32x4 (&acc)[2][2][4][2], const Unit& u, int wr, int wc, int fr, int fq) const {
        const float* src; float* dst; bf16_t* xb; unsigned* ss; const float scale = d->scale;
        { const float* s0 = d->src; float* d0 = d->dst; bf16_t* x0 = d->xb; unsigned* q0 = d->ss; const GAS float* s1; GAS float* d1; GAS bf16_t* x1; GAS unsigned* q1;
          asm volatile("" : "=v"(s1), "=v"(d1), "=v"(x1), "=v"(q1) : "0"(s0), "1"(d0), "2"(x0), "3"(q0)); src = (const float*)s1; dst = (float*)d1; xb = (bf16_t*)x1; ss = (unsigned*)q1; }
        const int row0 = u.pm * BM + wr * 64 + fr, col0 = u.pn * BM + wc * 32 + 8 * fq;
        float sq[8]; f32x4 cur[4], nxt[4];
        { const size_t off = (size_t)row0 * DM + col0;
#pragma unroll
          for (int bj = 0; bj < 2; ++bj) { cur[2 * bj] = *(const f32x4*)(src + off + bj * HALF); cur[2 * bj + 1] = *(const f32x4*)(src + off + bj * HALF + 4); } }
#pragma unroll
        for (int gi = 0; gi < 8; ++gi) { const int ai = gi >> 2, m = gi & 3;
            const size_t off = (size_t)(row0 + ai * HALF + m * 16) * DM + col0;
            if (gi + 1 < 8) { const size_t offn = (size_t)(row0 + ((gi + 1) >> 2) * HALF + ((gi + 1) & 3) * 16) * DM + col0;
#pragma unroll
                for (int bj = 0; bj < 2; ++bj) { nxt[2 * bj] = *(const f32x4*)(src + offn + bj * HALF); nxt[2 * bj + 1] = *(const f32x4*)(src + offn + bj * HALF + 4); } }
            float q = 0.f;
#pragma unroll
            for (int bj = 0; bj < 2; ++bj) { const f32x4 v0 = cur[2 * bj] + acc[ai][bj][m][0] * scale, v1 = cur[2 * bj + 1] + acc[ai][bj][m][1] * scale;
                *(f32x4*)(dst + off + bj * HALF) = v0; *(f32x4*)(dst + off + bj * HALF + 4) = v1;
                u32x4 w; w.x = pk(v0[0], v0[1]); w.y = pk(v0[2], v0[3]); w.z = pk(v1[0], v1[1]); w.w = pk(v1[2], v1[3]); *(u32x4*)(xb + off + bj * HALF) = w;
                q += v0[0] * v0[0] + v0[1] * v0[1] + v0[2] * v0[2] + v0[3] * v0[3] + v1[0] * v1[0] + v1[1] * v1[1] + v1[2] * v1[2] + v1[3] * v1[3]; }
            sq[gi] = q;
#pragma unroll
            for (int i = 0; i < 4; ++i) cur[i] = nxt[i]; }
#pragma unroll
        for (int gi = 0; gi < 8; ++gi) { float q = sq[gi]; q += __shfl_xor(q, 16); q += __shfl_xor(q, 32);
            if (fq == 0) __hip_atomic_fetch_add(ss + row0 + (gi >> 2) * HALF + (gi & 3) * 16, (unsigned)(q * 1024.0f + 0.5f), __ATOMIC_RELAXED, __HIP_MEMORY_SCOPE_AGENT); }
    }
};
__device__ __forceinline__ float gelu_tanh(float x) { const float u2 = 1.5957691216f * (x + 0.044715f * x * x * x); return x * sigm(u2); }
struct EpiBf16Act {
    static constexpr bool PERM = true, AFTER_DRAIN = false;
    bf16_t* O; int ldc; int gelu_tiles; const unsigned* ss; const LAS float* rtab;
    __device__ __forceinline__ void operator()(const f32x4 (&acc)[2][2][4][2], const Unit& u, int wr, int wc, int fr, int fq) const {
        const int row0 = u.pm * BM + wr * 64 + fr, col0 = u.pn * BM + wc * 32 + 8 * fq; const bool act = u.pn < gelu_tiles;
        float rsv[2][4]; row_scales(rsv, ss, rtab, u.pm, row0, wr * 64 + fr);
#pragma unroll
        for (int ai = 0; ai < 2; ++ai)
#pragma unroll
            for (int m = 0; m < 4; ++m) {
                bf16_t* rowp = O + (size_t)(row0 + ai * HALF + m * 16) * ldc + col0;
                const float rs = rsv[ai][m];
#pragma unroll
                for (int bj = 0; bj < 2; ++bj) {
                    f32x4 v0 = acc[ai][bj][m][0] * rs, v1 = acc[ai][bj][m][1] * rs;
                    if (act) {
#pragma unroll
                        for (int j = 0; j < 4; ++j) { v0[j] = gelu_tanh(v0[j]); v1[j] = gelu_tanh(v1[j]); } }
                    u32x4 w; w.x = pk(v0[0], v0[1]); w.y = pk(v0[2], v0[3]); w.z = pk(v1[0], v1[1]); w.w = pk(v1[2], v1[3]);
                    *(u32x4*)(rowp + bj * HALF) = w;
                }
            }
    }
};
struct EpiLora {
    static constexpr bool PERM = true, AFTER_DRAIN = false;
    float* wbuf; float* kkabuf; bf16_t* gbuf; const float* w0; const float* a0;
    __device__ __forceinline__ void operator()(const f32x4 (&acc)[2][2][4][2], const Unit& u, int wr, int wc, int fr, int fq) const {
        const int row0 = u.pm * BM + wr * 64 + fr, seg = u.pn >> 1, cl0 = (u.pn & 1) * 256 + wc * 32 + 8 * fq;
        if (seg < 2) {
            const float* bp = (seg == 0 ? w0 : a0) + cl0; float* dst = seg == 0 ? wbuf : kkabuf;
            f32x4 bv[2][2];
#pragma unroll
            for (int bj = 0; bj < 2; ++bj)
#pragma unroll
                for (int n = 0; n < 2; ++n) bv[bj][n] = *(const f32x4*)(bp + bj * HALF + 4 * n);
#pragma unroll
            for (int ai = 0; ai < 2; ++ai)
#pragma unroll
                for (int m = 0; m < 4; ++m) { float* rowp = dst + (size_t)(row0 + ai * HALF + m * 16) * 512 + cl0;
#pragma unroll
                    for (int bj = 0; bj < 2; ++bj)
#pragma unroll
                        for (int n = 0; n < 2; ++n) { f32x4 o;
#pragma unroll
                            for (int j = 0; j < 4; ++j) { const float sg = sigm(bv[bj][n][j] + acc[ai][bj][m][n][j]); o[j] = seg == 0 ? __expf(-0.606531f * sg) : sg; }
                            *(f32x4*)(rowp + bj * HALF + 4 * n) = o; } }
        } else {
#pragma unroll
            for (int ai = 0; ai < 2; ++ai)
#pragma unroll
                for (int m = 0; m < 4; ++m) { const size_t off = (size_t)(row0 + ai * HALF + m * 16) * 512 + cl0;
#pragma unroll
                    for (int bj = 0; bj < 2; ++bj) { const f32x4 v0 = acc[ai][bj][m][0], v1 = acc[ai][bj][m][1];
                        u32x4 w; w.x = pk(v0[0], v0[1]); w.y = pk(v0[2], v0[3]); w.z = pk(v1[0], v1[1]); w.w = pk(v1[2], v1[3]); *(u32x4*)(gbuf + off + bj * HALF) = w; } }
        }
    }
};
struct EpiVLora {
    static constexpr bool PERM = true, AFTER_DRAIN = false;
    const bf16_t* vsh; const bf16_t* vfirst; bf16_t* v2; const float* v0;
    __device__ __forceinline__ void operator()(const f32x4 (&acc)[2][2][4][2], const Unit& u, int wr, int wc, int fr, int fq) const {
        const int row0 = u.pm * BM + wr * 64 + fr, cl0 = u.pn * BM + wc * 32 + 8 * fq;
        f32x4 bv[2][2];
#pragma unroll
        for (int bj = 0; bj < 2; ++bj)
#pragma unroll
            for (int n = 0; n < 2; ++n) bv[bj][n] = *(const f32x4*)(v0 + cl0 + bj * HALF + 4 * n);
#pragma unroll
        for (int ai = 0; ai < 2; ++ai)
#pragma unroll
            for (int bj = 0; bj < 2; ++bj) {
                u32x4 av[4], fv[4];
#pragma unroll
                for (int m = 0; m < 4; ++m) { const size_t off = (size_t)(row0 + ai * HALF + m * 16) * 512 + cl0 + bj * HALF; av[m] = *(const u32x4*)(vsh + off); fv[m] = *(const u32x4*)(vfirst + off); }
#pragma unroll
                for (int m = 0; m < 4; ++m) { const size_t off = (size_t)(row0 + ai * HALF + m * 16) * 512 + cl0 + bj * HALF; float a8[8], f8[8], o8[8]; unpack8(av[m], a8); unpack8(fv[m], f8);
#pragma unroll
                    for (int e = 0; e < 8; ++e) o8[e] = a8[e] + (f8[e] - a8[e]) * sigm(bv[bj][e >> 2][e & 3] + acc[ai][bj][m][e >> 2][e & 3]);
                    *(u32x4*)(v2 + off) = pack8(o8); }
                __builtin_amdgcn_sched_barrier(0); }
    }
};
struct EpiGates {
    static constexpr bool PERM = true, AFTER_DRAIN = false;
    const bf16_t* xcg; float* bbuf; float* abuf; const float* ba; const float* bx; const float* lam;
    __device__ __forceinline__ void operator()(const f32x4 (&acc)[2][2][4][2], const Unit& u, int wr, int wc, int fr, int fq) const {
        const int row0 = (u.pm & 63) * BM + wr * 64 + fr, ch0 = u.pn * 128 + wc * 32 + 8 * fq;
        const bf16_t* xsrc = xcg + ((size_t)(ch0 >> 8) * MT) * 256 + (ch0 & 255);
        f32x4 bav[2], bxv[2], sp[2];
#pragma unroll
        for (int n = 0; n < 2; ++n) { bav[n] = *(const f32x4*)(ba + ch0 + 4 * n); bxv[n] = *(const f32x4*)(bx + ch0 + 4 * n); const f32x4 lv = *(const f32x4*)(lam + ch0 + 4 * n);
#pragma unroll
            for (int j = 0; j < 4; ++j) { const float y = __expf(-lv[j]);
                const float l1p = y < 0.02f ? y * (1.0f + y * (-0.5f + y * (0.33333333f + y * (-0.25f + y * 0.2f)))) : __logf(1.0f + y); sp[n][j] = -8.0f * l1p; } }
#pragma unroll
        for (int ai = 0; ai < 2; ++ai) {
            u32x4 xw[4];
#pragma unroll
            for (int m = 0; m < 4; ++m) xw[m] = *(const u32x4*)(xsrc + (size_t)(row0 + ai * HALF + m * 16) * 256);
#pragma unroll
            for (int m = 0; m < 4; ++m) { const size_t off = (size_t)(row0 + ai * HALF + m * 16) * 1280 + ch0; float xc[8]; unpack8(xw[m], xc);
#pragma unroll
                for (int n = 0; n < 2; ++n) { f32x4 ao, bo;
#pragma unroll
                    for (int j = 0; j < 4; ++j) { const float r = sigm(acc[ai][0][m][n][j] + bav[n][j]), ig = sigm(acc[ai][1][m][n][j] + bxv[n][j]); const float la = sp[n][j] * r, x2 = 2.0f * la;
                        ao[j] = __expf(la);
                        const float em = x2 > -0.25f ? -x2 * (1.0f + x2 * (0.5f + x2 * (0.16666667f + x2 * (0.041666668f + x2 * (0.0083333338f + x2 * (0.0013888889f + x2 * 0.0001984127f)))))) : 1.0f - __expf(x2);
                        bo[j] = sqrtf(fmaxf(em, 0.0f)) * ig * xc[4 * n + j]; }
                    *(f32x4*)(abuf + off + 4 * n) = ao; *(f32x4*)(bbuf + off + 4 * n) = bo; } }
            __builtin_amdgcn_sched_barrier(0); }
    }
};
struct GatesOrder {
    int G, c;
    __device__ __forceinline__ bool next(int i, Unit& u) const { const int L = i * G + c; if (L >= 640) return false; const int g = L >> 7, rem = L & 127; u.pm = g * 64 + (rem >> 1); u.pn = g * 2 + (rem & 1); return true; }
    __device__ __forceinline__ void a_ready(const Unit&) const {}
    __device__ __forceinline__ void done(const Unit&) const {}
};

__device__ __forceinline__ void transpose_job(const float* src, int K, int N, bf16_t* dst, int mode, LAS float* tile, const float* gvec) {
    const int tid = o_tid(), tn_cnt = N >> 6, ntiles = (K >> 6) * tn_cnt, G = o_grid();
    const int r = tid >> 4, c4 = (tid & 15) * 4, n = tid >> 3, ks = (tid & 7) * 8;
    int t = o_bid(); if (t >= ntiles) return;
    f32x4 cur[2], nxt[2];
    { const int tk = t / tn_cnt, tn = t - tk * tn_cnt;
#pragma unroll
      for (int h = 0; h < 2; ++h) cur[h] = *(const f32x4*)(src + (size_t)(tk * 64 + r + 32 * h) * N + tn * 64 + c4); }
#pragma unroll 1
    for (; t < ntiles; t += G) {
        const int tk = t / tn_cnt, tn = t - tk * tn_cnt, k0 = tk * 64, n0 = tn * 64;
        const int t2 = t + G;
        if (t2 < ntiles) { const int tk2 = t2 / tn_cnt, tn2 = t2 - tk2 * tn_cnt;
#pragma unroll
            for (int h = 0; h < 2; ++h) nxt[h] = *(const f32x4*)(src + (size_t)(tk2 * 64 + r + 32 * h) * N + tn2 * 64 + c4); }
#pragma unroll
        for (int h = 0; h < 2; ++h) { LAS float* d = tile + (r + 32 * h) * 65 + c4; d[0] = cur[h][0]; d[1] = cur[h][1]; d[2] = cur[h][2]; d[3] = cur[h][3]; }
        __syncthreads();
        { float v[8];
#pragma unroll
          for (int i = 0; i < 8; ++i) v[i] = tile[(ks + i) * 65 + n];
          if (gvec) { const f32x4 g0 = *(const f32x4*)(gvec + k0 + ks), g1 = *(const f32x4*)(gvec + k0 + ks + 4);
#pragma unroll
              for (int i = 0; i < 4; ++i) { v[i] *= g0[i]; v[4 + i] *= g1[i]; } }
          const int gn = n0 + n; const int R = mode == 0 ? gn : ((gn >> 7) * 256 + (gn & 127) + (mode == 2 ? 128 : 0));
          u32x4 w; w.x = pk(v[0], v[1]); w.y = pk(v[2], v[3]); w.z = pk(v[4], v[5]); w.w = pk(v[6], v[7]);
          *(u32x4*)(dst + (size_t)R * K + k0 + ks) = w; }
        __syncthreads();
        cur[0] = nxt[0]; cur[1] = nxt[1];
    }
}
__device__ __forceinline__ void convert_ffn(const Params& p, int l, int s, bf16_t* gu, bf16_t* dn, LAS float* tile) {
    const size_t wo = (size_t)(l * 2 + s) * 1024 * 2816; const float* gv = pin(p, I_NFFN) + (size_t)(l * 2 + s) * 1024;
    transpose_job(pin(p, I_WG) + wo, 1024, 2816, gu, 1, tile, gv);
    transpose_job(pin(p, I_WU) + wo, 1024, 2816, gu, 2, tile, gv);
    transpose_job(pin(p, I_WDN) + wo, 2816, 1024, dn, 0, tile, nullptr);
}
__device__ __forceinline__ void convert_mixer(const Params& p, int l, LAS float* tile) {
    unsigned char* ws = p.ws; const int i2 = l >> 1;
    const int gtid = o_bid() * 512 + o_tid(), gsz = o_grid() * 512;
    if ((l & 1) == 0) {
        transpose_job(pin(p, I_ABIN) + (size_t)i2 * 1024 * 3328, 1024, 3328, (bf16_t*)(ws + OFF_WIN), 0, tile, pin(p, I_NMIX) + (size_t)l * 1024);
        transpose_job(pin(p, I_ABOUT) + (size_t)i2 * 1024 * 1024, 1024, 1024, (bf16_t*)(ws + OFF_WOUT), 0, tile, nullptr);
        const float* wup = pin(p, I_WUP) + (size_t)i2 * 64 * 512; const float* aup = pin(p, I_AUP) + (size_t)i2 * 64 * 512; const float* gup = pin(p, I_GUP) + (size_t)i2 * 128 * 512;
        bf16_t* wl = (bf16_t*)(ws + OFF_WLORA);
        for (int e = gtid; e < 1536 * 256; e += gsz) { const int R = e >> 8, kk = e & 255, seg = R >> 9, c = R & 511; float v = 0.f;
            if (seg == 0) { if (kk < 64) v = wup[kk * 512 + c]; } else if (seg == 1) { if (kk >= 64 && kk < 128) v = aup[(kk - 64) * 512 + c]; } else { if (kk >= 128) v = gup[(kk - 128) * 512 + c]; }
            wl[e] = f2bf(v); }
        if (i2 == 1) { const float* vd = pin(p, I_VDN); const float* vu = pin(p, I_VUP); bf16_t* wv = (bf16_t*)(ws + OFF_WV);
            for (int e = gtid; e < 512 * 512; e += gsz) { const int n = e >> 9, k = e & 511; float a = 0.f;
#pragma unroll 8
                for (int j = 0; j < 32; ++j) a = fmaf(vd[k * 32 + j], vu[j * 512 + n], a);
                wv[e] = f2bf(a); } }
    } else {
        transpose_job(pin(p, I_CIN) + (size_t)i2 * 1024 * 2560, 1024, 2560, (bf16_t*)(ws + OFF_CIN), 0, tile, pin(p, I_NMIX) + (size_t)l * 1024);
        transpose_job(pin(p, I_COUT) + (size_t)i2 * 1280 * 1024, 1280, 1024, (bf16_t*)(ws + OFF_COUT), 0, tile, nullptr);
        const float* wa = pin(p, I_CWA) + (size_t)i2 * 10 * 128 * 128; const float* wx = pin(p, I_CWX) + (size_t)i2 * 10 * 128 * 128; bf16_t* wg = (bf16_t*)(ws + OFF_WGATES);
        for (int e = gtid; e < 2560 * 256; e += gsz) { const int R = e >> 8, kk = e & 255, pn = R >> 8, bj = (R >> 7) & 1, d = R & 127; float v = 0.f;
            if ((kk >> 7) == (pn & 1)) v = (bj ? wx : wa)[((size_t)pn * 128 + (kk & 127)) * 128 + d];
            wg[e] = f2bf(v); }
    }
}

__device__ __forceinline__ void prologue_phase(const float* x, bf16_t* xb, unsigned* ss) {
    const int wid = o_tid() >> 6, lane = o_tid() & 63;
    for (int i = o_bid() * 512 + o_tid(); i < 12 * MT; i += o_grid() * 512) ss[MT + i] = 0u;
#pragma unroll 1
    for (int row = (o_bid() * 8 + wid) * 2; row < MT; row += o_grid() * 16) {
        f32x4 v[2][4]; float sq[2] = {0.f, 0.f};
#pragma unroll
        for (int rr = 0; rr < 2; ++rr)
#pragma unroll
            for (int j = 0; j < 4; ++j) v[rr][j] = *(const f32x4*)(x + (size_t)(row + rr) * DM + j * 256 + lane * 4);
#pragma unroll
        for (int rr = 0; rr < 2; ++rr)
#pragma unroll
            for (int j = 0; j < 4; ++j) { sq[rr] += v[rr][j][0] * v[rr][j][0] + v[rr][j][1] * v[rr][j][1] + v[rr][j][2] * v[rr][j][2] + v[rr][j][3] * v[rr][j][3];
                u32x2 w; w.x = pk(v[rr][j][0], v[rr][j][1]); w.y = pk(v[rr][j][2], v[rr][j][3]); *(u32x2*)(xb + (size_t)(row + rr) * DM + j * 256 + lane * 4) = w; }
#pragma unroll
        for (int o = 32; o >= 1; o >>= 1) { sq[0] += __shfl_xor(sq[0], o); sq[1] += __shfl_xor(sq[1], o); }
        if (lane == 0) { ss[row] = (unsigned)(sq[0] * 1024.0f + 0.5f); ss[row + 1] = (unsigned)(sq[1] * 1024.0f + 0.5f); }
    }
}
template <bool FINAL> __device__ __forceinline__ void norm_phase(const float* x, const float* g, bf16_t* outb, float* outf) {
    const int wid = o_tid() >> 6, lane = o_tid() & 63;
    f32x4 gg[4];
#pragma unroll
    for (int j = 0; j < 4; ++j) gg[j] = *(const f32x4*)(g + j * 256 + lane * 4);
#pragma unroll 1
    for (int row = (o_bid() * 8 + wid) * 2; row < MT; row += o_grid() * 16) {
        f32x4 v[2][4]; float ss[2] = {0.f, 0.f};
#pragma unroll
        for (int rr = 0; rr < 2; ++rr)
#pragma unroll
            for (int j = 0; j < 4; ++j) v[rr][j] = *(const f32x4*)(x + (size_t)(row + rr) * DM + j * 256 + lane * 4);
#pragma unroll
        for (int rr = 0; rr < 2; ++rr) {
#pragma unroll
            for (int j = 0; j < 4; ++j) ss[rr] += v[rr][j][0] * v[rr][j][0] + v[rr][j][1] * v[rr][j][1] + v[rr][j][2] * v[rr][j][2] + v[rr][j][3] * v[rr][j][3]; }
#pragma unroll
        for (int o = 32; o >= 1; o >>= 1) { ss[0] += __shfl_xor(ss[0], o); ss[1] += __shfl_xor(ss[1], o); }
#pragma unroll
        for (int rr = 0; rr < 2; ++rr) { const float rs = 1.0f / sqrtf(ss[rr] * (1.0f / 1024.0f) + 1e-6f);
#pragma unroll
            for (int j = 0; j < 4; ++j) { const f32x4 y = v[rr][j] * rs * gg[j];
                if (FINAL) *(f32x4*)(outf + (size_t)(row + rr) * DM + j * 256 + lane * 4) = y;
                else { u32x2 w; w.x = pk(y[0], y[1]); w.y = pk(y[2], y[3]); *(u32x2*)(outb + (size_t)(row + rr) * DM + j * 256 + lane * 4) = w; } } }
    }
}

__device__ __forceinline__ float xrow16_max(float x) {
    auto s = __builtin_amdgcn_permlane16_swap(__float_as_uint(x), __float_as_uint(x), false, false);
    x = fmaxf(__uint_as_float(s[0]), __uint_as_float(s[1]));
    auto t = __builtin_amdgcn_permlane32_swap(__float_as_uint(x), __float_as_uint(x), false, false);
    return fmaxf(__uint_as_float(t[0]), __uint_as_float(t[1]));
}
__device__ __forceinline__ float xrow16_sum(float x) {
    auto s = __builtin_amdgcn_permlane16_swap(__float_as_uint(x), __float_as_uint(x), false, false);
    x = __uint_as_float(s[0]) + __uint_as_float(s[1]);
    auto t = __builtin_amdgcn_permlane32_swap(__float_as_uint(x), __float_as_uint(x), false, false);
    return __uint_as_float(t[0]) + __uint_as_float(t[1]);
}
__device__ __forceinline__ void attn_phase(const bf16_t* P, const float* relb, bf16_t* mix, LAS unsigned char* lds) {
    const int tid = o_tid(), wid = tid >> 6, lane = tid & 63, r = lane & 15, q = lane >> 4, h = wid;
    LAS float* bias = (LAS float*)lds;
    LAS bf16_t* vt = (LAS bf16_t*)(lds + 8 * 260 * 4) + wid * (64 * 40);
    for (int i = tid; i < 8 * 257; i += 512) bias[(i / 257) * 260 + (i % 257)] = relb[i];
    __syncthreads();
    const float bfar = bias[h * 260 + 256];
    for (int item = o_bid(); item < 256; item += o_grid()) {
        const int it = (item & 7) * 32 + (item >> 3);
        const int b = it >> 6, n = it & 63; const int tok0 = b * SEQ + n * 64;
        bf16x8 Qf[4][2];
#pragma unroll
        for (int qb = 0; qb < 4; ++qb)
#pragma unroll
            for (int ks = 0; ks < 2; ++ks) Qf[qb][ks] = *(const bf16x8*)(P + (size_t)(tok0 + 16 * qb + r) * 3328 + h * 64 + 32 * ks + 8 * q);
        f32x4 O[4][4]; float mrun[4], lrun[4];
#pragma unroll
        for (int a = 0; a < 4; ++a) { mrun[a] = -1e30f; lrun[a] = 0.f;
#pragma unroll
            for (int c = 0; c < 4; ++c) O[a][c] = (f32x4){0.f, 0.f, 0.f, 0.f}; }
        const int jc0 = n >= 8 ? n - 8 : 0, tile_end = (n + 1) * 2;
        const int vkey = lane >> 1, vd0 = (lane & 1) * 32;
        bf16x8 Kn[2][2]; u32x4 Vn[4];
        { const int kt0 = b * SEQ + jc0 * 64;
#pragma unroll
          for (int kb = 0; kb < 2; ++kb)
#pragma unroll
              for (int ks = 0; ks < 2; ++ks) Kn[kb][ks] = *(const bf16x8*)(P + (size_t)(kt0 + 16 * kb + r) * 3328 + 512 + h * 64 + 32 * ks + 8 * q);
          const bf16_t* vp = P + (size_t)(kt0 + vkey) * 3328 + 1024 + h * 64 + vd0;
#pragma unroll
          for (int i = 0; i < 4; ++i) Vn[i] = *(const u32x4*)(vp + 8 * i); }
#pragma unroll 1
        for (int tile = jc0 * 2; tile < tile_end; ++tile) {
            const int kp0 = tile * 32;
            bf16x8 Kf[2][2];
#pragma unroll
            for (int kb = 0; kb < 2; ++kb)
#pragma unroll
                for (int ks = 0; ks < 2; ++ks) Kf[kb][ks] = Kn[kb][ks];
            __builtin_amdgcn_wave_barrier();
#pragma unroll
            for (int i = 0; i < 4; ++i)
#pragma unroll
                for (int e = 0; e < 4; ++e) { const unsigned wv = Vn[i][e]; vt[(vd0 + 8 * i + 2 * e) * 40 + vkey] = (bf16_t)(wv & 0xffffu); vt[(vd0 + 8 * i + 2 * e + 1) * 40 + vkey] = (bf16_t)(wv >> 16); }
            __builtin_amdgcn_wave_barrier();
            if (tile + 1 < tile_end) { const int kt1 = b * SEQ + kp0 + 32;
#pragma unroll
                for (int kb = 0; kb < 2; ++kb)
#pragma unroll
                    for (int ks = 0; ks < 2; ++ks) Kn[kb][ks] = *(const bf16x8*)(P + (size_t)(kt1 + 16 * kb + r) * 3328 + 512 + h * 64 + 32 * ks + 8 * q);
                const bf16_t* vp = P + (size_t)(kt1 + vkey) * 3328 + 1024 + h * 64 + vd0;
#pragma unroll
                for (int i = 0; i < 4; ++i) Vn[i] = *(const u32x4*)(vp + 8 * i); }
            const bool far = kp0 + 31 + 128 <= n * 64;
            bf16x8 Pf[4];
            if (far) {
#pragma unroll
            for (int qb = 0; qb < 4; ++qb) {
                f32x4 S[2];
#pragma unroll
                for (int kb = 0; kb < 2; ++kb) { S[kb] = (f32x4){0.f, 0.f, 0.f, 0.f};
                    S[kb] = __builtin_amdgcn_mfma_f32_16x16x32_bf16(Kf[kb][0], Qf[qb][0], S[kb], 0, 0, 0);
                    S[kb] = __builtin_amdgcn_mfma_f32_16x16x32_bf16(Kf[kb][1], Qf[qb][1], S[kb], 0, 0, 0); }
                const int qpos = n * 64 + 16 * qb + r; float mx = -1e30f;
#pragma unroll
                    for (int kb = 0; kb < 2; ++kb)
#pragma unroll
                        for (int j = 0; j < 4; ++j) { const float sv = fmaf(S[kb][j], 0.125f, bfar); S[kb][j] = sv; mx = fmaxf(mx, sv); }
                mx = xrow16_max(mx);
                const float mnew = fmaxf(mrun[qb], mx), alpha = __expf(mrun[qb] - mnew); mrun[qb] = mnew;
                float ps = 0.f; float pv[8];
#pragma unroll
                for (int kb = 0; kb < 2; ++kb)
#pragma unroll
                    for (int j = 0; j < 4; ++j) { const float e = __expf(S[kb][j] - mnew); pv[kb * 4 + j] = e; ps += e; }
                lrun[qb] = lrun[qb] * alpha + ps;
#pragma unroll
                for (int db = 0; db < 4; ++db) O[db][qb] = O[db][qb] * alpha;
                u32x4 w; w.x = pk(pv[0], pv[1]); w.y = pk(pv[2], pv[3]); w.z = pk(pv[4], pv[5]); w.w = pk(pv[6], pv[7]);
                Pf[qb] = __builtin_bit_cast(bf16x8, w);
            }
            } else {
#pragma unroll
            for (int qb = 0; qb < 4; ++qb) {
                f32x4 S[2];
#pragma unroll
                for (int kb = 0; kb < 2; ++kb) { S[kb] = (f32x4){0.f, 0.f, 0.f, 0.f};
                    S[kb] = __builtin_amdgcn_mfma_f32_16x16x32_bf16(Kf[kb][0], Qf[qb][0], S[kb], 0, 0, 0);
                    S[kb] = __builtin_amdgcn_mfma_f32_16x16x32_bf16(Kf[kb][1], Qf[qb][1], S[kb], 0, 0, 0); }
                const int qpos = n * 64 + 16 * qb + r; float mx = -1e30f;
#pragma unroll
                    for (int kb = 0; kb < 2; ++kb)
#pragma unroll
                        for (int j = 0; j < 4; ++j) { const int dist = qpos - (kp0 + 16 * kb + 4 * q + j); const int idx = (dist < 128 ? dist : 128) + 128;
                            const float sv = fmaf(S[kb][j], 0.125f, bias[h * 260 + idx]); S[kb][j] = sv; mx = fmaxf(mx, sv); }
                mx = xrow16_max(mx);
                const float mnew = fmaxf(mrun[qb], mx), alpha = __expf(mrun[qb] - mnew); mrun[qb] = mnew;
                float ps = 0.f; float pv[8];
#pragma unroll
                for (int kb = 0; kb < 2; ++kb)
#pragma unroll
                    for (int j = 0; j < 4; ++j) { const float e = __expf(S[kb][j] - mnew); pv[kb * 4 + j] = e; ps += e; }
                lrun[qb] = lrun[qb] * alpha + ps;
#pragma unroll
                for (int db = 0; db < 4; ++db) O[db][qb] = O[db][qb] * alpha;
                u32x4 w; w.x = pk(pv[0], pv[1]); w.y = pk(pv[2], pv[3]); w.z = pk(pv[4], pv[5]); w.w = pk(pv[6], pv[7]);
                Pf[qb] = __builtin_bit_cast(bf16x8, w);
            }
            }
#pragma unroll
            for (int db = 0; db < 4; ++db) {
                const LAS bf16_t* vr = vt + (16 * db + r) * 40 + 4 * q;
                const u32x2 lo = *(const LAS u32x2*)vr, hi = *(const LAS u32x2*)(vr + 16);
                u32x4 w; w.x = lo.x; w.y = lo.y; w.z = hi.x; w.w = hi.y; const bf16x8 Vf = __builtin_bit_cast(bf16x8, w);
#pragma unroll
                for (int qb = 0; qb < 4; ++qb) O[db][qb] = __builtin_amdgcn_mfma_f32_16x16x32_bf16(Vf, Pf[qb], O[db][qb], 0, 0, 0);
            }
        }
#pragma unroll
        for (int qb = 0; qb < 4; ++qb) {
            const float l = xrow16_sum(lrun[qb]); const float inv = 1.0f / l;
            bf16_t* op = mix + (size_t)(tok0 + 16 * qb + r) * 1024 + h * 64 + 4 * q;
#pragma unroll
            for (int db = 0; db < 4; ++db) { const f32x4 o = O[db][qb] * inv; u32x2 w; w.x = pk(o[0], o[1]); w.y = pk(o[2], o[3]); *(u32x2*)(op + 16 * db) = w; }
        }
    }
    __syncthreads();
}

__device__ __forceinline__ void prep_phase(const bf16_t* P, const float* mu, const float* k_k, float* rbuf, float* kbuf, float* kkbuf, bf16_t* vbuf, bf16_t* alora) {
    const int tid = o_tid(), wid = tid >> 6, lane = tid & 63, c0 = lane * 8;
    float mur[8], muk[8], muv[8], mut[8], kkw[8];
#pragma unroll
    for (int e = 0; e < 8; ++e) { mur[e] = mu[c0 + e]; muk[e] = mu[512 + c0 + e]; muv[e] = mu[1024 + c0 + e]; mut[e] = lane < 32 ? mu[1536 + c0 + e] : 0.f; kkw[e] = k_k[c0 + e]; }
#pragma unroll 1
    for (int tok = o_bid() * 8 + wid; tok < MT; tok += o_grid() * 8) {
        const bool first = (tok & (SEQ - 1)) == 0;
        const bf16_t* pc = P + (size_t)tok * 3328 + 1536 + c0; const bf16_t* pp = first ? pc : pc - 3328;
        const u32x4 z = {0u, 0u, 0u, 0u};
        const u32x4 cr = *(const u32x4*)pc, ck = *(const u32x4*)(pc + 512), cv = *(const u32x4*)(pc + 1024), ct = lane < 32 ? *(const u32x4*)(pc + 1536) : z;
        u32x4 qr = *(const u32x4*)pp, qk = *(const u32x4*)(pp + 512), qv = *(const u32x4*)(pp + 1024), qt = lane < 32 ? *(const u32x4*)(pp + 1536) : z;
        if (first) { qr = z; qk = z; qv = z; qt = z; }
        float c[8], pv[8], o[8];
        unpack8(cr, c); unpack8(qr, pv);
#pragma unroll
        for (int e = 0; e < 8; ++e) o[e] = c[e] + (pv[e] - c[e]) * mur[e];
        { float* d = rbuf + (size_t)tok * 512 + c0; *(f32x4*)d = (f32x4){o[0], o[1], o[2], o[3]}; *(f32x4*)(d + 4) = (f32x4){o[4], o[5], o[6], o[7]}; }
        unpack8(ck, c); unpack8(qk, pv); float ss = 0.f;
#pragma unroll
        for (int e = 0; e < 8; ++e) { o[e] = c[e] + (pv[e] - c[e]) * muk[e]; const float kv = o[e] * kkw[e]; ss = fmaf(kv, kv, ss); }
        { float* d = kbuf + (size_t)tok * 512 + c0; *(f32x4*)d = (f32x4){o[0], o[1], o[2], o[3]}; *(f32x4*)(d + 4) = (f32x4){o[4], o[5], o[6], o[7]}; }
        ss += __shfl_xor(ss, 1); ss += __shfl_xor(ss, 2); ss += __shfl_xor(ss, 4);
        const float rn = 1.0f / sqrtf(fmaxf(ss, 1e-24f));
        { float* d = kkbuf + (size_t)tok * 512 + c0; *(f32x4*)d = (f32x4){o[0] * kkw[0] * rn, o[1] * kkw[1] * rn, o[2] * kkw[2] * rn, o[3] * kkw[3] * rn};
          *(f32x4*)(d + 4) = (f32x4){o[4] * kkw[4] * rn, o[5] * kkw[5] * rn, o[6] * kkw[6] * rn, o[7] * kkw[7] * rn}; }
        unpack8(cv, c); unpack8(qv, pv);
#pragma unroll
        for (int e = 0; e < 8; ++e) o[e] = c[e] + (pv[e] - c[e]) * muv[e];
        *(u32x4*)(vbuf + (size_t)tok * 512 + c0) = pack8(o);
        if (lane < 32) { unpack8(ct, c); unpack8(qt, pv);
#pragma unroll
            for (int e = 0; e < 8; ++e) { const float ts = c[e] + (pv[e] - c[e]) * mut[e]; o[e] = lane < 8 ? (2.0f * sigm(2.0f * ts) - 1.0f) : (lane < 16 ? ts : sigm(ts)); }
            *(u32x4*)(alora + (size_t)tok * 256 + c0) = pack8(o); }
    }
}

#define RL(x, k) __int_as_float(__builtin_amdgcn_readlane((x), (k)))
__device__ __forceinline__ void scan1_phase(float* wb, const float* kkb, float* kkab, float* kb, const float* rb, const bf16_t* vb, const float* k_a, const float* r_k, float* Pm, float* Hm) {
    const int wid = __builtin_amdgcn_readfirstlane(o_tid() >> 6), lane = o_tid() & 63;
#pragma unroll 1
    for (int bhc = o_bid() * 8 + wid; bhc < 2048; bhc += o_grid() * 8) {
        const int b = bhc >> 9, h = (bhc >> 6) & 7, c = bhc & 63;
        const size_t base0 = ((size_t)(b * SEQ + c * 64)) * 512 + h * 64 + lane;
        const float kav = k_a[h * 64 + lane], rkv = r_k[h * 64 + lane];
        float sP[64], sH[64];
#pragma unroll
        for (int k = 0; k < 64; ++k) { sP[k] = (k == lane) ? 1.f : 0.f; sH[k] = 0.f; }
        float nw = wb[base0], nkk = kkb[base0], nr = rb[base0], nv = bf2f(vb[base0]), nka, nk;
        { const float a = kkab[base0], ks = kb[base0]; nka = nkk * a; nk = ks * (1.0f + (a - 1.0f) * kav); }
#pragma unroll 1
        for (int t = 0; t < 64; ++t) { const size_t base = base0 + (size_t)t * 512;
            const int iw = __float_as_int(nw), ikk = __float_as_int(nkk), ika = __float_as_int(nka), ik = __float_as_int(nk), ir = __float_as_int(nr); const float vv = nv, pr = nr * nk * rkv;
            if (t + 1 < 64) { const size_t o = base + 512; nw = wb[o]; nkk = kkb[o]; nr = rb[o]; nv = bf2f(vb[o]); const float a = kkab[o], ks = kb[o]; nka = nkk * a; nk = ks * (1.0f + (a - 1.0f) * kav); }
            pg8::f32x2 aP2 = {0.f, 0.f}, aH2 = {0.f, 0.f};
#pragma unroll
            for (int k = 0; k < 64; k += 2) { const pg8::f32x2 kk2 = {RL(ikk, k), RL(ikk, k + 1)};
                aP2 = __builtin_elementwise_fma((pg8::f32x2){sP[k], sP[k + 1]}, kk2, aP2); aH2 = __builtin_elementwise_fma((pg8::f32x2){sH[k], sH[k + 1]}, kk2, aH2); }
            const float nP = -(aP2.x + aP2.y), nH = -(aH2.x + aH2.y);
            pg8::f32x2 q2 = {0.f, 0.f}, l2 = {0.f, 0.f};
#pragma unroll
            for (int k = 0; k < 64; k += 2) {
                const pg8::f32x2 w2 = {RL(iw, k), RL(iw, k + 1)}, ka2 = {RL(ika, k), RL(ika, k + 1)}, k2 = {RL(ik, k), RL(ik, k + 1)}, r2 = {RL(ir, k), RL(ir, k + 1)};
                pg8::f32x2 p2 = {sP[k], sP[k + 1]}, h2 = {sH[k], sH[k + 1]};
                p2 = __builtin_elementwise_fma(p2, w2, ka2 * nP);
                h2 = __builtin_elementwise_fma(h2, w2, __builtin_elementwise_fma(ka2, (pg8::f32x2){nH, nH}, k2 * vv));
                sP[k] = p2.x; sP[k + 1] = p2.y; sH[k] = h2.x; sH[k + 1] = h2.y;
                q2 = __builtin_elementwise_fma(p2, r2, q2); l2 = __builtin_elementwise_fma(h2, r2, l2); }
            kkab[base] = q2.x + q2.y;
            wb[base] = l2.x + l2.y;
            kb[base] = pr; }
        float* dP = Pm + (size_t)bhc * 4096 + lane * 64; float* dH = Hm + (size_t)bhc * 4096 + lane * 64;
#pragma unroll
        for (int k4 = 0; k4 < 16; ++k4) { *(f32x4*)(dP + 4 * k4) = (f32x4){sP[4 * k4], sP[4 * k4 + 1], sP[4 * k4 + 2], sP[4 * k4 + 3]}; *(f32x4*)(dH + 4 * k4) = (f32x4){sH[4 * k4], sH[4 * k4 + 1], sH[4 * k4 + 2], sH[4 * k4 + 3]}; }
    }
}
__device__ __forceinline__ void scan2_phase(const float* Pm, const float* Hm, float* Si, LAS float* lds) {
    const int tid = o_tid(), wid = tid >> 6, lane = tid & 63;
    for (int item = o_bid(); item < 256; item += o_grid()) {
        const int it = (item & 7) * 32 + (item >> 3);
        const int bh = it >> 3, rg = it & 7, v = rg * 8 + wid;
        const float* Pb = Pm + (size_t)bh * 64 * 4096 + tid * 8; const float* Hb = Hm + (size_t)bh * 64 * 4096 + v * 64 + lane; float* Sb = Si + (size_t)bh * 64 * 4096 + v * 64 + lane;
        float s = 0.f; f32x4 pre[4][2]; float hq[4];
#pragma unroll
        for (int d = 0; d < 4; ++d) { pre[d][0] = *(const f32x4*)(Pb + (size_t)d * 4096); pre[d][1] = *(const f32x4*)(Pb + (size_t)d * 4096 + 4); hq[d] = Hb[(size_t)d * 4096]; }
#pragma unroll 1
        for (int c0 = 0; c0 < 64; c0 += 4) {
#pragma unroll
            for (int pr = 0; pr < 2; ++pr) { const int c = c0 + 2 * pr;
                LAS float* buf = lds + ((c >> 1) & 1) * 8192;
                *(LAS f32x4*)(buf + tid * 8) = pre[2 * pr][0]; *(LAS f32x4*)(buf + tid * 8 + 4) = pre[2 * pr][1];
                *(LAS f32x4*)(buf + 4096 + tid * 8) = pre[2 * pr + 1][0]; *(LAS f32x4*)(buf + 4096 + tid * 8 + 4) = pre[2 * pr + 1][1];
                const float h0 = hq[2 * pr], h1 = hq[2 * pr + 1];
                __syncthreads();
                if (c + 4 < 64) {
#pragma unroll
                    for (int d = 0; d < 2; ++d) { pre[2 * pr + d][0] = *(const f32x4*)(Pb + (size_t)(c + 4 + d) * 4096); pre[2 * pr + d][1] = *(const f32x4*)(Pb + (size_t)(c + 4 + d) * 4096 + 4); hq[2 * pr + d] = Hb[(size_t)(c + 4 + d) * 4096]; } }
#pragma unroll
                for (int d = 0; d < 2; ++d) { Sb[(size_t)(c + d) * 4096] = s;
                    float acc = d == 0 ? h0 : h1; const int si = __float_as_int(s); const LAS float* bp = buf + d * 4096 + lane;
#pragma unroll
                    for (int i = 0; i < 64; ++i) acc = fmaf(__int_as_float(__builtin_amdgcn_readlane(si, i)), bp[i * 64], acc);
                    s = acc; } }
        }
        __syncthreads();
    }
}
__device__ __forceinline__ void scan3_phase(const float* rb, const float* olb, const float* qb, const float* kb, const bf16_t* vb, const bf16_t* gb, const float* Sinit,
                                            const float* ln_w, const float* ln_b, const float* r_k, bf16_t* mix, LAS float* lds) {
    const int wid = __builtin_amdgcn_readfirstlane(o_tid() >> 6), lane = o_tid() & 63;
    LAS float* ob = lds + wid * 4096;
#pragma unroll 1
    for (int bhc = o_bid() * 8 + wid; bhc < 2048; bhc += o_grid() * 8) {
        const int b = bhc >> 9, h = (bhc >> 6) & 7, c = bhc & 63;
        const size_t base0 = ((size_t)(b * SEQ + c * 64)) * 512 + h * 64;
        float s[64];
        { const float* sp = Sinit + (size_t)bhc * 4096 + lane * 64;
#pragma unroll
          for (int k4 = 0; k4 < 16; ++k4) { const f32x4 t4 = *(const f32x4*)(sp + 4 * k4); s[4 * k4] = t4[0]; s[4 * k4 + 1] = t4[1]; s[4 * k4 + 2] = t4[2]; s[4 * k4 + 3] = t4[3]; } }
        float qn[4], on[4];
#pragma unroll
        for (int d = 0; d < 4; ++d) { qn[d] = qb[base0 + (size_t)d * 512 + lane]; on[d] = olb[base0 + (size_t)d * 512 + lane]; }
#pragma unroll 1
        for (int t0 = 0; t0 < 64; t0 += 4) {
#pragma unroll
            for (int d = 0; d < 4; ++d) { const int t = t0 + d;
                const int qi = __float_as_int(qn[d]); float o0 = on[d], o1 = 0.f;
                if (t + 4 < 64) { qn[d] = qb[base0 + (size_t)(t + 4) * 512 + lane]; on[d] = olb[base0 + (size_t)(t + 4) * 512 + lane]; }
#pragma unroll
                for (int i = 0; i < 64; i += 2) { o0 = fmaf(s[i], __int_as_float(__builtin_amdgcn_readlane(qi, i)), o0); o1 = fmaf(s[i + 1], __int_as_float(__builtin_amdgcn_readlane(qi, i + 1)), o1); }
                ob[t * 64 + (lane ^ t)] = o0 + o1; }
        }
        { const int t = lane; const size_t tb = base0 + (size_t)t * 512; const LAS float* orow = ob + t * 64;
          float mean = 0.f;
#pragma unroll
          for (int v = 0; v < 64; ++v) mean += orow[v ^ t];
          mean *= (1.0f / 64.0f); float var = 0.f;
#pragma unroll
          for (int v = 0; v < 64; ++v) { const float d = orow[v ^ t] - mean; var = fmaf(d, d, var); }
          const float rstd = 1.0f / sqrtf(var * (1.0f / 64.0f) + 64e-5f);
          float bonus = 0.f;
#pragma unroll 4
          for (int k4 = 0; k4 < 16; ++k4) { const f32x4 pr = *(const f32x4*)(kb + tb + 4 * k4); bonus += (pr[0] + pr[1]) + (pr[2] + pr[3]); }
          bf16_t* op = mix + (size_t)(b * SEQ + c * 64 + t) * 1024 + 512 + h * 64;
#pragma unroll
          for (int v8 = 0; v8 < 8; ++v8) { const u32x4 vw = *(const u32x4*)(vb + tb + 8 * v8), gw = *(const u32x4*)(gb + tb + 8 * v8); float o8[8];
#pragma unroll
              for (int e = 0; e < 8; ++e) { const int v = 8 * v8 + e; const unsigned vwe = vw[e >> 1], gwe = gw[e >> 1];
                  const float vvv = (e & 1) ? __uint_as_float(vwe & 0xffff0000u) : bf2f(vwe & 0xffffu), gg = (e & 1) ? __uint_as_float(gwe & 0xffff0000u) : bf2f(gwe & 0xffffu);
                  const float on = (orow[v ^ t] - mean) * rstd * ln_w[h * 64 + v] + ln_b[h * 64 + v]; o8[e] = (on + bonus * vvv) * gg; }
              u32x4 w; w.x = pk(o8[0], o8[1]); w.y = pk(o8[2], o8[3]); w.z = pk(o8[4], o8[5]); w.w = pk(o8[6], o8[7]); *(u32x4*)(op + 8 * v8) = w; }
        }
    }
}

__device__ __forceinline__ void conv_phase(const bf16_t* P2, const float* cw, const float* cb, bf16_t* xcg) {
#pragma unroll 1
    for (int e = o_bid() * 512 + o_tid(); e < (MT / 8) * 160; e += o_grid() * 512) {
        const int run = e / 160, grp = e - run * 160, ch0 = grp * 8, tok0 = run * 8;
        float w[4][8], bb[8], win[3][8];
#pragma unroll
        for (int j = 0; j < 4; ++j) { const f32x4 a0 = *(const f32x4*)(cw + j * 1280 + ch0), a1 = *(const f32x4*)(cw + j * 1280 + ch0 + 4);
#pragma unroll
            for (int i = 0; i < 4; ++i) { w[j][i] = a0[i]; w[j][4 + i] = a1[i]; } }
        { const f32x4 a0 = *(const f32x4*)(cb + ch0), a1 = *(const f32x4*)(cb + ch0 + 4);
#pragma unroll
          for (int i = 0; i < 4; ++i) { bb[i] = a0[i]; bb[4 + i] = a1[i]; } }
        const bool head = (tok0 & (SEQ - 1)) == 0; const bf16_t* src = P2 + (size_t)tok0 * 2560 + 1280 + ch0;
#pragma unroll
        for (int j = 0; j < 3; ++j) { u32x4 v = {0u, 0u, 0u, 0u}; if (!head) v = *(const u32x4*)(src - (size_t)(3 - j) * 2560); unpack8(v, win[j]); }
        const int g2 = ch0 >> 8, col = ch0 & 255;
#pragma unroll
        for (int t = 0; t < 8; ++t) { float cur[8], o[8]; unpack8(*(const u32x4*)(src + (size_t)t * 2560), cur);
#pragma unroll
            for (int i = 0; i < 8; ++i) { o[i] = fmaf(w[3][i], cur[i], fmaf(w[2][i], win[2][i], fmaf(w[1][i], win[1][i], fmaf(w[0][i], win[0][i], bb[i])))); win[0][i] = win[1][i]; win[1][i] = win[2][i]; win[2][i] = cur[i]; }
            *(u32x4*)(xcg + ((size_t)g2 * MT + tok0 + t) * 256 + col) = pack8(o); }
    }
}
__device__ __forceinline__ void cscan1_phase(const float* ab, const float* bb, float* sA, float* sH) {
#pragma unroll 1
    for (int e = o_bid() * 512 + o_tid(); e < 4 * 64 * 320; e += o_grid() * 512) {
        const int bc = e / 320, c4 = (e - bc * 320) * 4, b = bc >> 6, c = bc & 63; const size_t o0 = (size_t)(b * SEQ + c * 64) * 1280 + c4;
        f32x4 A = {1.f, 1.f, 1.f, 1.f}, hh = {0.f, 0.f, 0.f, 0.f};
#pragma unroll 8
        for (int t = 0; t < 64; ++t) { const f32x4 av = *(const f32x4*)(ab + o0 + (size_t)t * 1280), bv = *(const f32x4*)(bb + o0 + (size_t)t * 1280); hh = av * hh + bv; A = A * av; }
        *(f32x4*)(sA + (size_t)bc * 1280 + c4) = A; *(f32x4*)(sH + (size_t)bc * 1280 + c4) = hh;
    }
}
__device__ __forceinline__ void cscan2_phase(const float* ab, const float* bb, const float* sA, const float* sH, const bf16_t* P2, bf16_t* y) {
#pragma unroll 1
    for (int e = o_bid() * 512 + o_tid(); e < 4 * 64 * 320; e += o_grid() * 512) {
        const int bc = e / 320, c4 = (e - bc * 320) * 4, b = bc >> 6, c = bc & 63; const size_t tok0 = (size_t)(b * SEQ + c * 64);
        f32x4 hh = {0.f, 0.f, 0.f, 0.f};
#pragma unroll 4
        for (int j = 0; j < c; ++j) { const size_t idx = (size_t)(b * 64 + j) * 1280 + c4; hh = hh * *(const f32x4*)(sA + idx) + *(const f32x4*)(sH + idx); }
#pragma unroll 8
        for (int t = 0; t < 64; ++t) { const size_t tok = tok0 + t; const f32x4 av = *(const f32x4*)(ab + tok * 1280 + c4), bv = *(const f32x4*)(bb + tok * 1280 + c4); hh = av * hh + bv;
            const u32x2 gw = *(const u32x2*)(P2 + tok * 2560 + c4);
            u32x2 w; w.x = pk(hh[0] * bf2f(gw.x & 0xffffu), hh[1] * __uint_as_float(gw.x & 0xffff0000u)); w.y = pk(hh[2] * bf2f(gw.y & 0xffffu), hh[3] * __uint_as_float(gw.y & 0xffff0000u));
            *(u32x2*)(y + tok * 1280 + c4) = w; }
    }
}

#define XB_TMO      128
#define XB_XCNT(j)  (256  + 64 * (j))
#define XB_XSUB(j)  (1280 + 64 * (j))
#define XB_XGEN(j)  (2304 + 64 * (j))
#define XB_TOP      3328
#define XB_TOPGEN   3392
#define XCD_BAR_WORDS 3456
#define XB_SPIN_CAP (1u << 18)

__device__ __forceinline__ unsigned xb_ld(unsigned* p)              { return __hip_atomic_load(p, __ATOMIC_RELAXED, __HIP_MEMORY_SCOPE_AGENT); }
__device__ __forceinline__ unsigned xb_add(unsigned* p, unsigned v) { return __hip_atomic_fetch_add(p, v, __ATOMIC_RELAXED, __HIP_MEMORY_SCOPE_AGENT); }
__device__ __forceinline__ unsigned xb_xcc_id() { return (unsigned)__builtin_amdgcn_s_getreg((3 << 11) | 20) & 0xFu; }
#define XB_SPIN(cond, bar) do { unsigned _sp = 0; while (cond) { __builtin_amdgcn_s_sleep(1); \
    if ((++_sp & 255u) == 0u) { if (xb_ld(&(bar)[XB_TMO])) break; if (_sp > XB_SPIN_CAP) { atomicAdd(&(bar)[XB_TMO], 1u); break; } } } } while (0)

struct XcdBarrier {
    unsigned* bar; unsigned x;
    volatile LAS unsigned* st;
};

__device__ __forceinline__ XcdBarrier xcd_barrier_post(unsigned* bar, volatile LAS unsigned* st) {
    XcdBarrier b; b.bar = bar; b.x = xb_xcc_id(); b.st = st;
    if (threadIdx.x == 0) (void)xb_add(&bar[XB_XCNT(b.x)], 1u);
    return b;
}
__device__ __forceinline__ void xcd_barrier_complete(unsigned* bar, unsigned x, unsigned& nloc, unsigned& nx) {
    const unsigned G = gridDim.x * gridDim.y * gridDim.z;
    unsigned sum, cnt, mine, sp = 0u;
    for (;;) {
        sum = 0u; cnt = 0u; mine = 0u;
#pragma unroll
        for (unsigned j = 0; j < 16; ++j) { const unsigned c = xb_ld(&bar[XB_XCNT(j)]); sum += c; cnt += (c > 0u) ? 1u : 0u; mine = (j == x) ? c : mine; }
        if (sum == G) break;
        __builtin_amdgcn_s_sleep(1);
        if ((++sp & 255u) == 0u) { if (xb_ld(&bar[XB_TMO])) break; if (sp > XB_SPIN_CAP) { atomicAdd(&bar[XB_TMO], 1u); break; } }
    }
    nloc = mine > 0u ? mine : 1u; nx = cnt > 0u ? cnt : 1u;
}

__device__ __forceinline__ void xcd_barrier(const XcdBarrier& b) {
    asm volatile("s_waitcnt vmcnt(0)" ::: "memory");
    __syncthreads();
    if (threadIdx.x == 0) {
        unsigned* bar = b.bar;
        __builtin_amdgcn_s_waitcnt(0);
        unsigned nloc = b.st[0], nx = b.st[1];
        if (nloc == 0u) { xcd_barrier_complete(bar, b.x, nloc, nx); b.st[0] = nloc; b.st[1] = nx; }
        const unsigned old = xb_add(&bar[XB_XSUB(b.x)], 1u);
        const unsigned gen = old / nloc;
        if (old + 1u == (gen + 1u) * nloc) {
            __builtin_amdgcn_fence(__ATOMIC_RELEASE, "agent");
            asm volatile("s_waitcnt vmcnt(0)" ::: "memory");
            const unsigned og = xb_add(&bar[XB_TOP], 1u);
            const unsigned tg = og / nx;
            if (og + 1u == (tg + 1u) * nx) xb_add(&bar[XB_TOPGEN], 1u);
            else XB_SPIN(xb_ld(&bar[XB_TOPGEN]) == tg, bar);
            __builtin_amdgcn_fence(__ATOMIC_ACQUIRE, "agent");
            xb_add(&bar[XB_XGEN(b.x)], 1u);
            asm volatile("s_waitcnt vmcnt(0)" ::: "memory");
        } else {
            XB_SPIN(xb_ld(&bar[XB_XGEN(b.x)]) == gen, bar);
            __builtin_amdgcn_fence(__ATOMIC_ACQUIRE, "agent");
            asm volatile("s_waitcnt vmcnt(0)" ::: "memory");
        }
    }
    __syncthreads();
}


constexpr int PH_PER_LAYER = 14, PH_TOTAL = 4 * PH_PER_LAYER + 1;
__host__ __device__ inline bool phase_skipped(int idx) { const int l = idx / PH_PER_LAYER, s = idx - l * PH_PER_LAYER; if (idx >= 4 * PH_PER_LAYER) return false;
    return ((l & 1) && s == 9) || (s == 0 && l > 0) || s == 3 || s == 11; }
__global__ __launch_bounds__(512, 2) void mega(Params p, int first, int last) {
    extern __shared__ __attribute__((aligned(16))) unsigned char shm[];
    LAS unsigned char* lds = (LAS unsigned char*)shm;
#if MODE_COOP
    volatile LAS unsigned* xst = (volatile LAS unsigned*)(lds + 131072);
    if (threadIdx.x == 0) { xst[0] = 0u; xst[1] = 0u; xst[2] = 0u; xst[3] = 0u; }
    __syncthreads();
    const XcdBarrier xb = xcd_barrier_post((unsigned*)(p.ws + OFF_BAR), xst);
#endif
    for (int idx = first; idx < last; ++idx) {
        GAS unsigned char* wsg; GAS float* xog; asm volatile("" : "=s"(wsg), "=s"(xog) : "0"(p.ws), "1"(p.out));
        unsigned char* ws = (unsigned char*)wsg; float* xo = (float*)xog;
        bf16_t* xbf = (bf16_t*)(ws + OFF_XB); unsigned* ssb = (unsigned*)(ws + OFF_SS);
        const int l = idx / PH_PER_LAYER, s = idx - l * PH_PER_LAYER, odd = l & 1, i2 = l >> 1;
        if (phase_skipped(idx)) continue;
#if MODE_COOP
        if (idx > first) { if (last == -12345) cg::this_grid().sync(); xcd_barrier(xb); }
#endif
        if (idx == 4 * PH_PER_LAYER) { norm_phase<true>(xo, pin(p, I_NFIN), nullptr, xo); continue; }
        unsigned char* ar = ws + OFF_AR; const EvenMap em = even_map(i2);
        bf16_t* w9gu = (bf16_t*)(ws + OFF_W9); bf16_t* w9dn = (bf16_t*)(ws + OFF_W9 + SZ_WGU); bf16_t* wagu = (bf16_t*)(ws + OFF_WA); bf16_t* wadn = (bf16_t*)(ws + OFF_WA + SZ_WGU);
        bf16_t* mix = (bf16_t*)(ws + OFF_W9);
        if (s == 0) { prologue_phase(pin(p, I_X), xbf, ssb); convert_ffn(p, 0, 0, w9gu, w9dn, (LAS float*)lds); convert_mixer(p, 0, (LAS float*)lds); continue; }
        if (s == 4) convert_ffn(p, l, 1, wagu, wadn, (LAS float*)lds);
        if (s == 12 && l < 3) { convert_ffn(p, l + 1, 0, w9gu, w9dn, (LAS float*)lds); convert_mixer(p, l + 1, (LAS float*)lds); }
        int ek = -1; const bf16_t* gA = nullptr; const bf16_t* gB = nullptr; int gN = 0, gK = 0;
        const float* r_src = nullptr; float r_scale = 0.f; unsigned* r_ss = nullptr; bf16_t* b_O = nullptr; int b_ldc = 0, b_gelu = 0; const unsigned* ssin = nullptr;
        if (s == 1 || s == 12) { ek = 0; gA = xbf; gB = s == 1 ? w9gu : wagu; gN = 5632; gK = 1024; ssin = ssb + (size_t)(l * 3 + (s == 12 ? 2 : 0)) * MT; }
        else if (s == 2 || s == 13) { ek = 1; gA = (const bf16_t*)(ws + OFF_FF); gB = s == 2 ? w9dn : wadn; gN = 1024; gK = 2816;
            r_src = (l == 0 && s == 2) ? pin(p, I_X) : xo; r_scale = 0.5f; r_ss = ssb + (size_t)(s == 2 ? l * 3 + 1 : (l + 1) * 3) * MT; }
        else if (s == 10) { ek = 1; gN = 1024; r_src = xo; r_scale = 1.0f; r_ss = ssb + (size_t)(l * 3 + 2) * MT;
            if (!odd) { gA = mix; gB = (const bf16_t*)(ws + OFF_WOUT); gK = 1024; } else { gA = (const bf16_t*)(ws + OFF_XCG); gB = (const bf16_t*)(ws + OFF_COUT); gK = 1280; } }
        else if (s == 4) { ek = 2; gA = xbf; gK = 1024; ssin = ssb + (size_t)(l * 3 + 1) * MT;
            if (!odd) { gB = (const bf16_t*)(ws + OFF_WIN); gN = 3328; b_O = (bf16_t*)(ar + em.P); b_ldc = 3328; b_gelu = 0; }
            else { gB = (const bf16_t*)(ws + OFF_CIN); gN = 2560; b_O = (bf16_t*)(ws + OFF_P2); b_ldc = 2560; b_gelu = 5; } }
        if (ek >= 0) {
            const pg8::Gemm g{gA, gB, MT, gN, gK};
            pg8::StaticOrder S; S.init(MT, gN, o_grid(), o_bid());
            LAS float* rtab = (LAS float*)(lds + 131072 + 256);
            if (ek != 1) { Unit u0; fill_row_scales(rtab, ssin, S.next(0, u0) ? u0.pm : 0); }
            if (ek == 0) { const EpiSwiglu E{(bf16_t*)(ws + OFF_FF), ssin, rtab}; pg8::gemm_phase<EpiSwiglu, pg8::StaticOrder, false>(lds, g, S, E, nullptr); }
            else if (ek == 1) { LAS ResidDesc* rd = (LAS ResidDesc*)(lds + 131072 + 64);
                if (threadIdx.x == 0) { rd->src = r_src; rd->dst = xo; rd->xb = xbf; rd->ss = r_ss; rd->scale = r_scale; rd->pad = 0; }
                __syncthreads();
                const EpiResid E{rd}; pg8::gemm_phase<EpiResid, pg8::StaticOrder, false>(lds, g, S, E, nullptr); }
            else { const EpiBf16Act E{b_O, b_ldc, b_gelu, ssin, rtab}; pg8::gemm_phase<EpiBf16Act, pg8::StaticOrder, false>(lds, g, S, E, nullptr); }
            continue;
        }
        if (!odd) {
            float* rbuf = (float*)(ar + em.r); float* kbuf = (float*)(ar + em.k); float* kkbuf = (float*)(ar + em.kk); float* wbuf = (float*)(ar + em.w); float* kkabuf = (float*)(ar + em.kka);
            bf16_t* gbuf = (bf16_t*)(ar + em.g); bf16_t* vfirst = (bf16_t*)(ws + OFF_VF); bf16_t* vsh = (bf16_t*)(ar + em.vsh); bf16_t* v2 = (bf16_t*)(ar + em.v2); bf16_t* alora = (bf16_t*)(ar + em.al);
            const bf16_t* vscan = i2 == 0 ? vfirst : v2; const bf16_t* Pb = (const bf16_t*)(ar + em.P);
            float* Pm = (float*)(ar + em.pm); float* Hm = (float*)(ar + em.hm); float* Sim = (float*)(ar + em.si);
            if (s == 5) {
                prep_phase(Pb, pin(p, I_MU) + (size_t)i2 * 1792, pin(p, I_KK) + (size_t)i2 * 512, rbuf, kbuf, kkbuf, i2 == 0 ? vfirst : vsh, alora);
                attn_phase(Pb, pin(p, I_RELB) + (size_t)i2 * 8 * 257, mix, lds);
            } else if (s == 6) {
                { pg8::Gemm gl{alora, (const bf16_t*)(ws + OFF_WLORA), MT, 1536, 256}; pg8::StaticOrder S; S.init(MT, 1536, o_grid(), o_bid());
                  EpiLora E{wbuf, kkabuf, gbuf, pin(p, I_W0) + (size_t)i2 * 512, pin(p, I_A0) + (size_t)i2 * 512};
                  pg8::gemm_phase<EpiLora, pg8::StaticOrder, false>(lds, gl, S, E, nullptr); }
                if (i2 == 1) { pg8::Gemm gv{vsh, (const bf16_t*)(ws + OFF_WV), MT, 512, 512}; pg8::StaticOrder S; S.init(MT, 512, o_grid(), o_bid());
                  EpiVLora E{vsh, vfirst, v2, pin(p, I_V0)};
                  pg8::gemm_phase<EpiVLora, pg8::StaticOrder, false>(lds, gv, S, E, nullptr); }
            } else if (s == 7) scan1_phase(wbuf, kkbuf, kkabuf, kbuf, rbuf, vscan, pin(p, I_KA) + (size_t)i2 * 512, pin(p, I_RK) + (size_t)i2 * 512, Pm, Hm);
            else if (s == 8) scan2_phase(Pm, Hm, Sim, (LAS float*)lds);
            else if (s == 9) scan3_phase(rbuf, wbuf, kkabuf, kbuf, vscan, gbuf, Sim, pin(p, I_LNW) + (size_t)i2 * 512, pin(p, I_LNB) + (size_t)i2 * 512, pin(p, I_RK) + (size_t)i2 * 512, mix, (LAS float*)lds);
        } else {
            const bf16_t* P2 = (const bf16_t*)(ws + OFF_P2); float* xc = (float*)(ws + OFF_XC); bf16_t* xcg = (bf16_t*)(ws + OFF_XCG); float* ab = (float*)(ws + OFF_A);
            float* sA = (float*)(ws + OFF_SA); float* sH = (float*)(ws + OFF_SH);
            if (s == 5) conv_phase(P2, pin(p, I_CCW) + (size_t)i2 * 4 * 1280, pin(p, I_CCB) + (size_t)i2 * 1280, xcg);
            else if (s == 6) { pg8::Gemm gg{xcg, (const bf16_t*)(ws + OFF_WGATES), 5 * MT, 2560, 256}; GatesOrder S{o_grid(), o_bid()};
                EpiGates E{xcg, xc, ab, pin(p, I_CBA) + (size_t)i2 * 1280, pin(p, I_CBX) + (size_t)i2 * 1280, pin(p, I_LAM) + (size_t)i2 * 1280};
                pg8::gemm_phase<EpiGates, GatesOrder, false>(lds, gg, S, E, nullptr); }
            else if (s == 7) cscan1_phase(ab, xc, sA, sH);
            else if (s == 8) cscan2_phase(ab, xc, sA, sH, P2, xcg);
        }
    }
}

extern "C" void kernel_launch(void* const* d_in, const int* in_sizes, int n_in, void* d_out, int out_size, void* d_ws, size_t ws_size, hipStream_t stream) {
    static int grid = 0;
    if (grid == 0) {
        if (n_in != 33 || out_size != MT * DM || ws_size < WS_NEED) { fprintf(stderr, "kernel_launch: unexpected shapes (n_in %d, out %d, ws %zu, need %zu)\n", n_in, out_size, ws_size, (size_t)WS_NEED); grid = -1; return; }
        int dev = 0, cus = 0, per_cu = 0;
        hipGetDevice(&dev); hipDeviceGetAttribute(&cus, hipDeviceAttributeMultiprocessorCount, dev);
        if (hipFuncSetAttribute((const void*)mega, hipFuncAttributeMaxDynamicSharedMemorySize, LDS_BYTES) != hipSuccess) { fprintf(stderr, "kernel_launch: hipFuncSetAttribute failed\n"); grid = -1; return; }
        if (hipOccupancyMaxActiveBlocksPerMultiprocessor(&per_cu, (const void*)mega, 512, LDS_BYTES) != hipSuccess || per_cu < 1) { fprintf(stderr, "kernel_launch: occupancy query says %d\n", per_cu); per_cu = 1; }
        (void)hipGetLastError();
        grid = cus * (per_cu > 1 ? 1 : per_cu); if (grid > 256) grid = 256;
    }
    if (grid < 0) return;
    Params p{}; for (int i = 0; i < 33; ++i) p.in[i] = (const float*)d_in[i];
    p.out = (float*)d_out; p.ws = (unsigned char*)d_ws;
#if MODE_COOP
    if (hipMemsetAsync((unsigned char*)d_ws + OFF_BAR, 0, 16384, stream) != hipSuccess) { fprintf(stderr, "kernel_launch: memset of barrier words failed\n"); return; }
    int first = 0, last = PH_TOTAL; void* args[] = {&p, &first, &last};
    hipError_t e = hipLaunchCooperativeKernel((const void*)mega, dim3(grid), dim3(512), args, LDS_BYTES, stream);
    if (e != hipSuccess) fprintf(stderr, "cooperative launch failed: %s (grid %d)\n", hipGetErrorString(e), grid);
#else
    for (int idx = 0; idx < PH_TOTAL; ++idx) {
        if (phase_skipped(idx)) continue;
        hipLaunchKernelGGL(mega, dim3(grid), dim3(512), LDS_BYTES, stream, p, idx, idx + 1);
    }
#endif
}
```
